# Optimizing an MI355X kernel written in HIP

```python
import math
import jax, jax.numpy as jnp
from jax import lax
import numpy as np

D_MODEL = 2048
BATCH = 1
SEQ = 8192
DEPTH = 1

N_MEM = 256
MEM_HEADS = 4
MEM_HD = 256
BRANCH_WIDTH = 1024
MEM_WIDTH = MEM_HEADS * MEM_HD
HG_HEADS = 8
HG_DK = 128
HG_DV = 128
HG_WIDTH = HG_HEADS * HG_DK
HG_CHUNK = 64
MLA_HEADS = 8
MLA_Q_RANK = 512
MLA_KV_RANK = 512
MLA_NOPE = 128
MLA_ROPE = 64
MLA_V = 128
MLA_QK = MLA_NOPE + MLA_ROPE
MLA_WIDTH = MLA_HEADS * MLA_V
ROPE_THETA = 10000.0
Q_BLOCK = 128
N_BRANCH = 3
D_FF = -(-8 * D_MODEL // (3 * 256)) * 256
ALPHA = (2.0 * DEPTH) ** 0.25
BETA = (8.0 * DEPTH) ** -0.25
LN_EPS = 1e-5
RMS_EPS = 1e-6
IN_SPLITS = (HG_WIDTH, HG_WIDTH, HG_WIDTH, HG_WIDTH, HG_WIDTH,
             MLA_Q_RANK, MLA_KV_RANK, MLA_ROPE, MEM_WIDTH, N_BRANCH * D_MODEL)
IN_WIDTH = sum(IN_SPLITS)

kernel_name = "hybrid_hgrn2_mla_memory_deepnorm_encoder"


def _split(a, sizes):
    idx, acc = [], 0
    for s in sizes[:-1]:
        acc += s
        idx.append(acc)
    return jnp.split(a, idx, axis=-1)


def _layernorm(x, g, b):
    xf = x.astype(jnp.float32)
    mu = jnp.mean(xf, -1, keepdims=True)
    xc = xf - mu
    var = jnp.mean(xc * xc, -1, keepdims=True)
    return (xc * lax.rsqrt(var + LN_EPS) * g.astype(jnp.float32) + b.astype(jnp.float32)).astype(x.dtype)


def _rmsnorm(x, g):
    xf = x.astype(jnp.float32)
    ms = jnp.mean(xf * xf, -1, keepdims=True)
    return (xf * lax.rsqrt(ms + RMS_EPS) * g.astype(jnp.float32)).astype(x.dtype)


def _rope(x, cos, sin):
    xf = x.astype(jnp.float32)
    x1, x2 = jnp.split(xf, 2, axis=-1)
    return jnp.concatenate([x1 * cos - x2 * sin, x2 * cos + x1 * sin], -1).astype(x.dtype)


def _chunk_gla(q, k, v, log_f):
    Z, B, H, T, dk = q.shape
    dv = v.shape[-1]
    n = T // HG_CHUNK

    def to_chunks(a):
        a = a.reshape(Z, B, H, n, HG_CHUNK, a.shape[-1])
        return jnp.moveaxis(a, 3, 0)

    tri = jnp.tril(jnp.ones((HG_CHUNK, HG_CHUNK), dtype=bool))[:, :, None]

    def step(S, inp):
        qc, kc, vc, gc = inp
        b = jnp.cumsum(gc, axis=-2)
        inter = jnp.einsum('zbhtk,zbhkv->zbhtv', qc * jnp.exp(b), S)
        diff = b[..., :, None, :] - b[..., None, :, :]
        decay = jnp.exp(jnp.where(tri, diff, -jnp.inf))
        att = jnp.einsum('zbhtk,zbhsk,zbhtsk->zbhts', qc, kc, decay)
        intra = jnp.einsum('zbhts,zbhsv->zbhtv', att, vc)
        b_last = b[..., -1:, :]
        S = jnp.swapaxes(jnp.exp(b_last), -1, -2) * S + jnp.einsum(
            'zbhsk,zbhsv->zbhkv', kc * jnp.exp(b_last - b), vc)
        return S, inter + intra

    S0 = jnp.zeros((Z, B, H, dk, dv), jnp.float32)
    _, o = lax.scan(step, S0, (to_chunks(q), to_chunks(k), to_chunks(v), to_chunks(log_f)))
    o = jnp.moveaxis(o, 0, 3)
    return o.reshape(Z, B, H, T, dv)


def _hgrn2_branch(q_raw, i_raw, f_fw_raw, f_bw_raw, g_raw, lb, norm_g):
    B, S, _ = q_raw.shape
    f32 = jnp.float32

    def heads(a):
        a = a.reshape(a.shape[:-1] + (HG_HEADS, -1))
        return jnp.swapaxes(a, -2, -3)

    q = heads(jax.nn.silu(q_raw.astype(f32)))
    v = heads(i_raw.astype(f32))
    f_raw = jnp.stack([f_fw_raw, f_bw_raw]).astype(f32)
    lbz = lb[:, None, None, :]
    f = lbz + (1.0 - lbz) * jax.nn.sigmoid(f_raw)
    k = heads(1.0 - f)
    log_f = heads(jnp.log(f))
    flip = lambda a: jnp.flip(a, axis=-2)
    qz = jnp.stack([q, flip(q)])
    vz = jnp.stack([v, flip(v)])
    kz = jnp.stack([k[0], flip(k[1])])
    gz = jnp.stack([log_f[0], flip(log_f[1])])
    o = _chunk_gla(qz, kz, vz, gz)
    o = o[0] + flip(o[1])
    o = _rmsnorm(jnp.swapaxes(o, 1, 2), norm_g)
    o = o.reshape(B, S, HG_WIDTH) * jax.nn.sigmoid(g_raw.astype(f32))
    return o.astype(q_raw.dtype)


def _mla_branch(cq_raw, ckv_raw, krope_raw, cos, sin, g_cq, g_ckv, w_uq, w_ukv):
    B, S, _ = cq_raw.shape
    q = (_rmsnorm(cq_raw, g_cq) @ w_uq).reshape(B, S, MLA_HEADS, MLA_QK)
    q = jnp.concatenate([q[..., :MLA_NOPE],
                         _rope(q[..., MLA_NOPE:], cos[:, :, None, :], sin[:, :, None, :])], -1)
    kv = (_rmsnorm(ckv_raw, g_ckv) @ w_ukv).reshape(B, S, MLA_HEADS, MLA_NOPE + MLA_V)
    k_rope = _rope(krope_raw, cos, sin)
    k = jnp.concatenate([kv[..., :MLA_NOPE],
                         jnp.broadcast_to(k_rope[:, :, None, :], (B, S, MLA_HEADS, MLA_ROPE))], -1)
    v = kv[..., MLA_NOPE:]
    scale = MLA_QK ** -0.5
    qb = jnp.moveaxis(q.reshape(B, S // Q_BLOCK, Q_BLOCK, MLA_HEADS, MLA_QK), 1, 0)

    def attend(qblk):
        s = jnp.einsum('bqhd,bkhd->bhqk', qblk, k).astype(jnp.float32) * scale
        p = jax.nn.softmax(s, axis=-1).astype(v.dtype)
        return jnp.einsum('bhqk,bkhd->bqhd', p, v)

    o = lax.map(attend, qb)
    return jnp.moveaxis(o, 0, 1).reshape(B, S, MLA_WIDTH)


def _memory_branch(q_raw, mem, w_kv):
    B, S, _ = q_raw.shape
    M = mem.shape[1]
    q = q_raw.reshape(B, S, MEM_HEADS, MEM_HD)
    kv = (mem @ w_kv).reshape(B, M, 2, MEM_HEADS, MEM_HD)
    k, v = kv[:, :, 0], kv[:, :, 1]
    s = jnp.einsum('bqhd,bmhd->bhqm', q, k).astype(jnp.float32) * (MEM_HD ** -0.5)
    p = jax.nn.softmax(s, axis=-1).astype(v.dtype)
    return jnp.einsum('bhqm,bmhd->bqhd', p, v).reshape(B, S, MEM_WIDTH)


def setup_inputs(seed: int = 0) -> dict:
    key = jax.random.key(seed)
    ks = jax.random.split(key, 24)
    f32 = jnp.float32
    L = DEPTH

    def nrm(k, shape, scale):
        return jax.random.normal(k, shape, f32) * scale

    def gain(k, shape):
        return 1.0 + 0.02 * jax.random.normal(k, shape, f32)

    return {
        "x": nrm(ks[0], (BATCH, SEQ, D_MODEL), 1.0),
        "mem": nrm(ks[1], (BATCH, N_MEM, D_MODEL), 1.0),
        "positions": jnp.tile(jnp.arange(SEQ, dtype=jnp.int32)[None, :], (BATCH, 1)),
        "ln_emb_g": gain(ks[2], (D_MODEL,)),
        "ln_emb_b": nrm(ks[3], (D_MODEL,), 0.02),
        "hgrn_lb_logits": nrm(ks[4], (2, DEPTH + 1, HG_WIDTH), 0.5),
        "w_in": nrm(ks[5], (L, D_MODEL, IN_WIDTH), D_MODEL ** -0.5),
        "hgrn_norm_g": gain(ks[6], (L, HG_DV)),
        "mla_g_cq": gain(ks[7], (L, MLA_Q_RANK)),
        "mla_g_ckv": gain(ks[8], (L, MLA_KV_RANK)),
        "mla_w_uq": nrm(ks[9], (L, MLA_Q_RANK, MLA_HEADS * MLA_QK), MLA_Q_RANK ** -0.5),
        "mla_w_ukv": nrm(ks[10], (L, MLA_KV_RANK, MLA_HEADS * (MLA_NOPE + MLA_V)), MLA_KV_RANK ** -0.5),
        "mem_w_kv": nrm(ks[11], (L, D_MODEL, 2 * MEM_WIDTH), D_MODEL ** -0.5),
        "w_branch": nrm(ks[12], (L, N_BRANCH, BRANCH_WIDTH, D_MODEL), BETA * BRANCH_WIDTH ** -0.5),
        "w_o": nrm(ks[13], (L, D_MODEL, D_MODEL), BETA * D_MODEL ** -0.5),
        "ln1_g": gain(ks[14], (L, D_MODEL)),
        "ln1_b": nrm(ks[15], (L, D_MODEL), 0.02),
        "w_ffn_gate": nrm(ks[16], (L, D_MODEL, D_FF), D_MODEL ** -0.5),
        "w_ffn_up": nrm(ks[17], (L, D_MODEL, D_FF), D_MODEL ** -0.5),
        "w_ffn_down": nrm(ks[18], (L, D_FF, D_MODEL), BETA * D_FF ** -0.5),
        "ln2_g": gain(ks[19], (L, D_MODEL)),
        "ln2_b": nrm(ks[20], (L, D_MODEL), 0.02),
    }


def reference(x, mem, positions, ln_emb_g, ln_emb_b, hgrn_lb_logits, w_in, hgrn_norm_g,
              mla_g_cq, mla_g_ckv, mla_w_uq, mla_w_ukv, mem_w_kv, w_branch, w_o,
              ln1_g, ln1_b, w_ffn_gate, w_ffn_up, w_ffn_down, ln2_g, ln2_b):
    B, S, D = x.shape
    f32 = jnp.float32
    half = MLA_ROPE // 2
    inv_freq = jnp.power(ROPE_THETA, -jnp.arange(half, dtype=f32) / half)
    ang = positions.astype(f32)[..., None] * inv_freq
    cos, sin = jnp.cos(ang), jnp.sin(ang)
    lb_all = jnp.cumsum(jax.nn.softmax(hgrn_lb_logits.astype(f32), axis=1), axis=1)

    h = _layernorm(x, ln_emb_g, ln_emb_b)
    for l in range(DEPTH):
        proj = h @ w_in[l]
        (q_hg, i_hg, f_fw, f_bw, g_hg, c_q, c_kv, k_rope, q_mem, gates) = _split(proj, IN_SPLITS)
        y_hg = _hgrn2_branch(q_hg, i_hg, f_fw, f_bw, g_hg, lb_all[:, l], hgrn_norm_g[l])
        y_mla = _mla_branch(c_q, c_kv, k_rope, cos, sin, mla_g_cq[l], mla_g_ckv[l],
                            mla_w_uq[l], mla_w_ukv[l])
        y_mem = _memory_branch(q_mem, mem, mem_w_kv[l])
        gsig = jax.nn.sigmoid(gates.astype(f32)).astype(h.dtype).reshape(B, S, N_BRANCH, D)
        merged = (gsig[:, :, 0] * (y_hg @ w_branch[l, 0])
                  + gsig[:, :, 1] * (y_mla @ w_branch[l, 1])
                  + gsig[:, :, 2] * (y_mem @ w_branch[l, 2]))
        mix = merged @ w_o[l]
        h = _layernorm(ALPHA * h + mix, ln1_g[l], ln1_b[l])
        ff = (jax.nn.silu(h @ w_ffn_gate[l]) * (h @ w_ffn_up[l])) @ w_ffn_down[l]
        h = _layernorm(ALPHA * h + ff, ln2_g[l], ln2_b[l])
    return h
```

```cpp
#include <hip/hip_runtime.h>
#include <hip/hip_cooperative_groups.h>
#include <cstdio>
#include <cstdint>
namespace cg = cooperative_groups;

#define LAS __attribute__((address_space(3)))
typedef unsigned short bf16_t;
typedef short bf16x8 __attribute__((ext_vector_type(8)));
typedef short s16x4 __attribute__((ext_vector_type(4)));
typedef float f32x4 __attribute__((ext_vector_type(4)));
typedef float f32x16 __attribute__((ext_vector_type(16)));
typedef unsigned u32x4 __attribute__((ext_vector_type(4)));
typedef unsigned u32x2 __attribute__((ext_vector_type(2)));

constexpr int S = 8192, DM = 2048, NMEM = 256, DFF = 5632;
constexpr int NINP = 13568;
constexpr float ALPHA = 1.189207115002721f;
constexpr float LN_EPS = 1e-5f, RMS_EPS = 1e-6f;

constexpr size_t MiB = 1u << 20;
constexpr size_t WS_SSQ = 262144, WS_STATS = 65536, WS_LB = 131072;
constexpr size_t WS_COS = 1 * MiB, WS_SIN = 2 * MiB, WS_DVEC = 3 * MiB;
constexpr size_t WS_WIN_T = 4 * MiB, WS_H0B = 57 * MiB;
constexpr size_t WS_WUQ_T = 89 * MiB, WS_WUKV_T = 89 * MiB + 1536 * 1024, WS_WKV_T = 92 * MiB + 512 * 1024, WS_MEMB = 100 * MiB + 512 * 1024;
constexpr size_t WS_KVM = 102 * MiB, WS_VMT = 102 * MiB + 512 * 1024, WS_KR = 103 * MiB;
constexpr size_t WS_QH = 104 * MiB, WS_VH = 120 * MiB, WS_GF = 136 * MiB, WS_GH = 168 * MiB;
constexpr size_t WS_CQ = 184 * MiB, WS_CKV = 192 * MiB, WS_QM = 200 * MiB, WS_GS = 216 * MiB;
constexpr size_t WS_HS = 312 * MiB, WS_YA = 84 * MiB, WS_WBR_T = 393 * MiB, WS_WO_T = 405 * MiB, WS_END = 413 * MiB;
constexpr size_t WS_KB = 4 * MiB, WS_VB = 20 * MiB, WS_QB = 36 * MiB, WS_SC = 60 * MiB;
constexpr size_t WS_PM = 184 * MiB;
constexpr size_t WS_YH = 52 * MiB, WS_YM = 68 * MiB;
constexpr size_t WS_MERGED = 104 * MiB, WS_MERGEDB = 168 * MiB;
constexpr size_t WS_R1 = 104 * MiB, WS_H1B = 168 * MiB;
constexpr size_t WS_WGU_T = 312 * MiB, WS_WD_T = 356 * MiB;
constexpr size_t WS_ACT = 216 * MiB;

constexpr int LDS_BYTES = 150 * 1024;

__device__ __forceinline__ float bf2f(bf16_t v) { return __uint_as_float((unsigned)v << 16); }
__device__ __forceinline__ unsigned f2bf(float f) { unsigned u = __float_as_uint(f); return (u + 0x7fffu + ((u >> 16) & 1u)) >> 16; }
__device__ __forceinline__ unsigned pk2(float lo, float hi) { return f2bf(lo) | (f2bf(hi) << 16); }
typedef __bf16 bf16x2_t __attribute__((ext_vector_type(2)));
typedef float f32x2_t __attribute__((ext_vector_type(2)));
__device__ __forceinline__ unsigned cvt_pk_bf16(float lo, float hi) { f32x2_t v = {lo, hi}; bf16x2_t b = __builtin_convertvector(v, bf16x2_t); return __builtin_bit_cast(unsigned, b); }
__device__ __forceinline__ u32x2 pk4(f32x4 v) { u32x2 w; w.x = cvt_pk_bf16(v[0], v[1]); w.y = cvt_pk_bf16(v[2], v[3]); return w; }
__device__ __forceinline__ f32x4 unpk4(u32x2 w) { f32x4 v; v[0] = __uint_as_float(w.x << 16); v[1] = __uint_as_float(w.x & 0xffff0000u); v[2] = __uint_as_float(w.y << 16); v[3] = __uint_as_float(w.y & 0xffff0000u); return v; }
__device__ __forceinline__ float wave_sum(float v) {
#pragma unroll
    for (int o = 1; o < 64; o <<= 1) v += __shfl_xor(v, o);
    return v;
}
__device__ __forceinline__ float wave_max(float v) {
#pragma unroll
    for (int o = 1; o < 64; o <<= 1) v = fmaxf(v, __shfl_xor(v, o));
    return v;
}
__device__ __forceinline__ float sigmoidf_(float v) { return __builtin_amdgcn_rcpf(1.f + __expf(-v)); }
#define LDS_WAIT() asm volatile("s_waitcnt lgkmcnt(0)" ::: "memory")

namespace pg8 {
constexpr int BM = 256, BK = 64, HALF = 128, HTB = HALF * BK * 2, STAGE_BYTES = 8 * HTB, NXCD = 8, WGM = 8;
__host__ __device__ __forceinline__ int lds_byte(int r, int c) { const int st = (r >> 4) * 2 + (c >> 5), rr = r & 15, cc = c & 31, ob = rr * 64 + cc * 2; return st * 1024 + (ob ^ (((ob >> 9) & 1) << 5)); }
__host__ __device__ __forceinline__ void stage_rc(int b, int& R, int& C) { const int st = b / 1024, sb = b % 1024, swz = sb ^ (((sb >> 9) & 1) << 5); R = (st >> 1) * 16 + swz / 64; C = (st & 1) * 32 + (swz % 64) / 2; }

struct Unit { int pm, pn, z; };
struct Sched {
    int nM, nN, nZ, nwg, G, c;
    const char* A0; const char* B;
    long a_pm, a_pn, a_z, b_pn, b_z;
    __device__ __forceinline__ void init(int M, int N, int nZ_, int G_, int c_) { nM = M / BM; nN = N / BM; nZ = nZ_; nwg = nM * nN; G = G_; c = c_; }
    __device__ __forceinline__ bool next(int i, Unit& u) const {
        const int z = i % nZ; const long L = (long)(i / nZ) * G + c; if (L >= nwg) return false;
        int wgid = (int)L; { const int q = nwg / NXCD, r = nwg % NXCD, xcd = wgid % NXCD, off = wgid / NXCD; wgid = (xcd < r ? xcd * (q + 1) : r * (q + 1) + (xcd - r) * q) + off; }
        const int nig = WGM * nN, gid = wgid / nig, fm = gid * WGM, gsz = (nM - fm) < WGM ? (nM - fm) : WGM;
        u.pm = fm + ((wgid % nig) % gsz); u.pn = (wgid % nig) / gsz; u.z = z; return true;
    }
    __device__ __forceinline__ const char* aptr(const Unit& u) const { return A0 + u.pm * a_pm + u.pn * a_pn + u.z * a_z; }
    __device__ __forceinline__ const char* bptr(const Unit& u) const { return B + u.pn * b_pn + u.z * b_z; }
};

template <class Epi, bool ALIGN_EPI>
__device__ __forceinline__ void gemm_phase(LAS unsigned char* lds, const int lda, const int ldb, const int K, const Sched& S, const Epi& E) {
    const int tid = threadIdx.x, wid = __builtin_amdgcn_readfirstlane(tid >> 6), lane = tid & 63, wr = wid >> 2, wc = wid & 3, fr = lane & 15, fq = lane >> 4;
    const int nt = K / BK;
    unsigned voffA[2], voffB[2];
#pragma unroll
    for (int i = 0; i < 2; ++i) { int R, C; stage_rc(tid * 16 + i * 8192, R, C); voffA[i] = (unsigned)(R * lda + C) * 2u; voffB[i] = (unsigned)(R * ldb + C) * 2u; }
    const size_t kstep = (size_t)(BK * 2);
    const size_t hstepA = (size_t)HALF * lda * 2, hstepB = (size_t)HALF * ldb * 2;
    const unsigned ldsw = (unsigned)wid * 1024u;
    const int aoff = lds_byte(wr * 64 + fr, fq * 8), boff = lds_byte(wc * 32 + fr, fq * 8);
#define PG8_SA(b, h) (((b) * 2 + (h)) * HTB)
#define PG8_SB(b, h) ((4 + (b) * 2 + (h)) * HTB)
#define PG8_STAGE(bufoff, gbase, voff) do { _Pragma("unroll") for (int _i = 0; _i < 2; ++_i) \
        __builtin_amdgcn_global_load_lds((const unsigned*)((const char*)(gbase) + (voff)[_i]), (LAS unsigned*)(lds + (bufoff) + ldsw + _i * 8192), 16, 0, 0); } while (0)
#define PG8_LDA(dst, b, h) do { _Pragma("unroll") for (int m = 0; m < 4; ++m) _Pragma("unroll") for (int k = 0; k < 2; ++k) dst[m][k] = *(const LAS bf16x8*)(lds + PG8_SA(b, h) + aoff + m * 2048 + k * 1024); } while (0)
#define PG8_LDB(dst, b, h) do { _Pragma("unroll") for (int n = 0; n < 2; ++n) _Pragma("unroll") for (int k = 0; k < 2; ++k) dst[n][k] = *(const LAS bf16x8*)(lds + PG8_SB(b, h) + boff + n * 2048 + k * 1024); } while (0)
#define PG8_MMA(ai, bj, At, Bt) do { __builtin_amdgcn_s_setprio(1); _Pragma("unroll") for (int m = 0; m < 4; ++m) _Pragma("unroll") for (int n = 0; n < 2; ++n) _Pragma("unroll") for (int k = 0; k < 2; ++k) \
        acc[ai][bj][m][n] = __builtin_amdgcn_mfma_f32_16x16x32_bf16(Bt[n][k], At[m][k], acc[ai][bj][m][n], 0, 0, 0); __builtin_amdgcn_s_setprio(0); } while (0)
#define PG8_WAIT_V(n) asm volatile("s_waitcnt vmcnt(" #n ")" ::: "memory")
#define PG8_WAIT_L(n) asm volatile("s_waitcnt lgkmcnt(" #n ")" ::: "memory")
#define PG8_BAR __builtin_amdgcn_s_barrier()
#define PG8_SCHED __builtin_amdgcn_sched_barrier(0)
    Unit cur, nxt; int ui = 0;
    if (!S.next(0, cur)) return;
    f32x4 acc[2][2][4][2];
#pragma unroll
    for (int a = 0; a < 2; ++a)
#pragma unroll
        for (int b = 0; b < 2; ++b)
#pragma unroll
            for (int m = 0; m < 4; ++m)
#pragma unroll
                for (int n = 0; n < 2; ++n) acc[a][b][m][n] = (f32x4){0.f, 0.f, 0.f, 0.f};
    bf16x8 At[4][2], B0[2][2], B1[2][2];
    const char* cA = S.aptr(cur); const char* cB = S.bptr(cur);
    PG8_STAGE(PG8_SB(0, 0), cB, voffB); PG8_STAGE(PG8_SB(0, 1), cB + hstepB, voffB); PG8_STAGE(PG8_SA(0, 0), cA, voffA); PG8_STAGE(PG8_SA(0, 1), cA + hstepA, voffA);
    if (wr == 1) PG8_BAR;
    PG8_WAIT_V(2); PG8_BAR;
    PG8_STAGE(PG8_SB(1, 0), cB + kstep, voffB); PG8_STAGE(PG8_SA(1, 0), cA + kstep, voffA); PG8_STAGE(PG8_SB(1, 1), cB + hstepB + kstep, voffB);
    PG8_WAIT_V(6); PG8_BAR;
    for (;;) {
        const bool has_next = S.next(ui + 1, nxt);
        const char* nA = has_next ? S.aptr(nxt) : cA; const char* nB = has_next ? S.bptr(nxt) : cB;
        for (int t = 0; t < nt; t += 2) {
            const bool last = (t == nt - 2);
            const char* a1 = cA + (size_t)(t + 1) * kstep;
            const char* a2 = last ? nA : cA + (size_t)(t + 2) * kstep; const char* b2 = last ? nB : cB + (size_t)(t + 2) * kstep;
            const char* a3 = a2 + kstep; const char* b3 = b2 + kstep;
            PG8_LDB(B0, 0, 0); PG8_LDB(B1, 0, 1); PG8_SCHED; PG8_LDA(At, 0, 0); PG8_STAGE(PG8_SA(1, 1), a1 + hstepA, voffA);
            PG8_WAIT_V(8); PG8_WAIT_L(0); PG8_BAR; PG8_MMA(0, 0, At, B0); PG8_MMA(0, 1, At, B1); PG8_BAR; PG8_SCHED;
            PG8_LDA(At, 0, 1); PG8_STAGE(PG8_SB(0, 0), b2, voffB); PG8_STAGE(PG8_SB(0, 1), b2 + hstepB, voffB); PG8_STAGE(PG8_SA(0, 0), a2, voffA);
            PG8_WAIT_V(8); PG8_WAIT_L(0); PG8_BAR; PG8_MMA(1, 0, At, B0); PG8_MMA(1, 1, At, B1); PG8_BAR; PG8_SCHED;
            PG8_LDB(B0, 1, 0); PG8_LDB(B1, 1, 1); PG8_SCHED; PG8_LDA(At, 1, 0); PG8_STAGE(PG8_SA(0, 1), a2 + hstepA, voffA);
            PG8_WAIT_V(8); PG8_WAIT_L(0); PG8_BAR; PG8_MMA(0, 0, At, B0); PG8_MMA(0, 1, At, B1); PG8_BAR; PG8_SCHED;
            PG8_LDA(At, 1, 1); PG8_STAGE(PG8_SB(1, 0), b3, voffB); PG8_STAGE(PG8_SB(1, 1), b3 + hstepB, voffB); PG8_STAGE(PG8_SA(1, 0), a3, voffA);
            PG8_WAIT_V(8); PG8_WAIT_L(0); PG8_BAR; PG8_MMA(1, 0, At, B0); PG8_MMA(1, 1, At, B1); PG8_BAR; PG8_SCHED;
        }
        if constexpr (ALIGN_EPI) { if (wr == 0) PG8_BAR; }
        E(acc, cur, wr, wc, fr, fq);
        if (!has_next) break;
#pragma unroll
        for (int a = 0; a < 2; ++a)
#pragma unroll
            for (int b = 0; b < 2; ++b)
#pragma unroll
                for (int m = 0; m < 4; ++m)
#pragma unroll
                    for (int n = 0; n < 2; ++n) acc[a][b][m][n] = (f32x4){0.f, 0.f, 0.f, 0.f};
        cur = nxt; cA = nA; cB = nB; ++ui;
        if constexpr (ALIGN_EPI) { if (wr == 1) PG8_BAR; }
    }
    PG8_WAIT_V(0);
    if constexpr (!ALIGN_EPI) { if (wr == 0) PG8_BAR; }
    PG8_BAR;
#undef PG8_SA
#undef PG8_SB
#undef PG8_STAGE
#undef PG8_LDA
#undef PG8_LDB
#undef PG8_MMA
#undef PG8_WAIT_V
#undef PG8_WAIT_L
#undef PG8_BAR
#undef PG8_SCHED
}

#define EPI_ARGS const f32x4 (&acc)[2][2][4][2], const Unit& u, int wr, int wc, int fr, int fq
#define EPI_ROWS for (int ai = 0; ai < 2; ++ai) for (int m = 0; m < 4; ++m)
#define EPI_COLS for (int bj = 0; bj < 2; ++bj) for (int n = 0; n < 2; ++n)

struct EpiStore {
    bf16_t* O; int ldc; float scale;
    __device__ __forceinline__ void operator()(EPI_ARGS) const {
        const int row0 = u.pm * BM + wr * 64 + fr, col0 = u.pn * BM + wc * 32 + 4 * fq;
#pragma unroll
        EPI_ROWS { bf16_t* rp = O + (size_t)(row0 + ai * HALF + m * 16) * ldc + col0;
#pragma unroll
            EPI_COLS { *(u32x2*)(rp + bj * HALF + n * 16) = pk4(acc[ai][bj][m][n] * scale); } }
    }
};

struct EpiP1 {
    bf16_t *QH, *VH, *GF, *GH, *CQ, *CKV, *QM, *GS, *KR; float* SSQ; const float *LB, *COS, *SIN;
    __device__ __forceinline__ void operator()(EPI_ARGS) const {
        const int pn = u.pn; const int row0 = u.pm * BM + wr * 64 + fr; const int ct = wc * 32 + 4 * fq;
        if (pn == 52) {
            if (wc < 2) {
                const int i0 = 16 * wc + 4 * fq;
#pragma unroll
                EPI_ROWS { const int row = row0 + ai * HALF + m * 16;
                    const f32x4 cs = *(const f32x4*)(COS + (size_t)row * 32 + i0), sn = *(const f32x4*)(SIN + (size_t)row * 32 + i0);
                    const f32x4 x1 = acc[ai][0][m][0], x2 = acc[ai][0][m][1];
                    const f32x4 o1 = x1 * cs - x2 * sn, o2 = x2 * cs + x1 * sn;
                    bf16_t* rp = KR + (size_t)row * 64 + 32 * wc + 4 * fq;
                    *(u32x2*)(rp) = pk4(o1); *(u32x2*)(rp + 16) = pk4(o2); }
            }
            return;
        }
        int op, ld, c0, ssq = -1; bf16_t* dst; const float* lbp = nullptr;
        if (pn < 4) { op = 1; dst = QH; ld = 1024; c0 = 256 * pn; }
        else if (pn < 8) { op = 0; dst = VH; ld = 1024; c0 = 256 * (pn - 4); }
        else if (pn < 16) { const int z = (pn >= 12) ? 1 : 0; op = 3; dst = GF + (size_t)z * S * 1024; ld = 1024; c0 = 256 * ((pn - 8) & 3); lbp = LB + z * 1024 + c0 + ct; }
        else if (pn < 20) { op = 2; dst = GH; ld = 1024; c0 = 256 * (pn - 16); }
        else if (pn < 22) { op = 0; dst = CQ; ld = 512; c0 = 256 * (pn - 20); ssq = 0; }
        else if (pn < 24) { op = 0; dst = CKV; ld = 512; c0 = 256 * (pn - 22); ssq = 1; }
        else if (pn < 28) { op = 0; dst = QM; ld = 1024; c0 = 256 * (pn - 24); }
        else { op = 2; dst = GS; ld = 6144; c0 = 256 * (pn - 28); }
        f32x4 lbv[2][2];
#pragma unroll
        EPI_COLS lbv[bj][n] = (op == 3) ? *(const f32x4*)(lbp + bj * HALF + n * 16) : (f32x4){0.f, 0.f, 0.f, 0.f};
#pragma unroll
        EPI_ROWS { const int row = row0 + ai * HALF + m * 16; bf16_t* rp = dst + (size_t)row * ld + c0 + ct; float ss = 0.f;
#pragma unroll
            EPI_COLS { f32x4 v = acc[ai][bj][m][n];
                if (op != 0) {
#pragma unroll
                    for (int e = 0; e < 4; ++e) { const float x = v[e]; const float sg = sigmoidf_(x);
                        float r = sg; if (op == 1) r = x * sg; else if (op == 3) { const float lb = lbv[bj][n][e]; r = __logf(lb + (1.f - lb) * sg); }
                        v[e] = r; }
                }
                ss += (v[0] * v[0] + v[1] * v[1]) + (v[2] * v[2] + v[3] * v[3]);
                *(u32x2*)(rp + bj * HALF + n * 16) = pk4(v); }
            if (ssq >= 0) { ss += __shfl_xor(ss, 16); ss += __shfl_xor(ss, 32); if (fq == 0) SSQ[((size_t)ssq * S + row) * 8 + (pn & 1) * 4 + wc] = ss; }
        }
    }
};

struct EpiQ {
    bf16_t* QB; const float *SSQ, *COS, *SIN;
    __device__ __forceinline__ void operator()(EPI_ARGS) const {
        const int row0 = u.pm * BM + wr * 64 + fr;
#pragma unroll
        EPI_ROWS { const int row = row0 + ai * HALF + m * 16; const f32x4 sa = *(const f32x4*)(SSQ + (size_t)row * 8), sb2 = *(const f32x4*)(SSQ + (size_t)row * 8 + 4); const float rstd = rsqrtf((((sa[0] + sa[1]) + (sa[2] + sa[3])) + ((sb2[0] + sb2[1]) + (sb2[2] + sb2[3]))) * (1.f / 512.f) + RMS_EPS);
#pragma unroll
            for (int bj = 0; bj < 2; ++bj) { const int gg = 8 * u.pn + 4 * bj + wc, part = gg % 6;
                f32x4 x1 = acc[ai][bj][m][0] * rstd, x2 = acc[ai][bj][m][1] * rstd;
                if (part >= 4) { const int i0 = (part - 4) * 16 + 4 * fq;
                    const f32x4 cs = *(const f32x4*)(COS + (size_t)row * 32 + i0), sn = *(const f32x4*)(SIN + (size_t)row * 32 + i0);
                    const f32x4 o1 = x1 * cs - x2 * sn, o2 = x2 * cs + x1 * sn; x1 = o1; x2 = o2; }
                bf16_t* rp = QB + (size_t)row * 1536 + 32 * gg + 4 * fq;
                *(u32x2*)(rp) = pk4(x1); *(u32x2*)(rp + 16) = pk4(x2); } }
    }
};
struct EpiKV {
    bf16_t *KB, *VB; const float* SSQ;
    __device__ __forceinline__ void operator()(EPI_ARGS) const {
        const int row0 = u.pm * BM + wr * 64 + fr; const int c = u.pn * 128 + wc * 32 + 4 * fq;
#pragma unroll
        EPI_ROWS { const int row = row0 + ai * HALF + m * 16; const f32x4 sa = *(const f32x4*)(SSQ + (size_t)row * 8), sb2 = *(const f32x4*)(SSQ + (size_t)row * 8 + 4); const float rstd = rsqrtf((((sa[0] + sa[1]) + (sa[2] + sa[3])) + ((sb2[0] + sb2[1]) + (sb2[2] + sb2[3]))) * (1.f / 512.f) + RMS_EPS);
#pragma unroll
            for (int n = 0; n < 2; ++n) { *(u32x2*)(KB + (size_t)row * 1024 + c + 16 * n) = pk4(acc[ai][0][m][n] * rstd); *(u32x2*)(VB + (size_t)row * 1024 + c + 16 * n) = pk4(acc[ai][1][m][n] * rstd); } }
    }
};
struct EpiMerge {
    const bf16_t* GS; float* MG; bf16_t* MGB;
    __device__ __forceinline__ void operator()(EPI_ARGS) const {
        const int row0 = u.pm * BM + wr * 64 + fr, col0 = u.pn * BM + wc * 32 + 4 * fq; const int z = u.z, gz = (3 - z) % 3;
#pragma unroll
        EPI_ROWS { const size_t row = (size_t)(row0 + ai * HALF + m * 16);
#pragma unroll
            EPI_COLS { const int col = col0 + bj * HALF + n * 16;
                const f32x4 g = unpk4(*(const u32x2*)(GS + row * 6144 + gz * 2048 + col));
                f32x4 v = g * acc[ai][bj][m][n];
                if (z > 0) v += *(const f32x4*)(MG + row * DM + col);
                if (z < 2) *(f32x4*)(MG + row * DM + col) = v; else *(u32x2*)(MGB + row * DM + col) = pk4(v); } }
    }
};
struct EpiWo {
    const float *X, *STATS, *G, *Bv; float* R1;
    __device__ __forceinline__ void operator()(EPI_ARGS) const {
        const int row0 = u.pm * BM + wr * 64 + fr, col0 = u.pn * BM + wc * 32 + 4 * fq;
        f32x4 gv[2][2], bv[2][2];
#pragma unroll
        EPI_COLS { gv[bj][n] = *(const f32x4*)(G + col0 + bj * HALF + n * 16); bv[bj][n] = *(const f32x4*)(Bv + col0 + bj * HALF + n * 16); }
#pragma unroll
        EPI_ROWS { const size_t row = (size_t)(row0 + ai * HALF + m * 16); const float mean = STATS[2 * row], rstd = STATS[2 * row + 1];
#pragma unroll
            EPI_COLS { const int col = col0 + bj * HALF + n * 16; const f32x4 x = *(const f32x4*)(X + row * DM + col);
                const f32x4 h = (x - mean) * rstd * gv[bj][n] + bv[bj][n];
                *(f32x4*)(R1 + row * DM + col) = h * ALPHA + acc[ai][bj][m][n]; } }
    }
};
struct EpiGU {
    bf16_t* ACT;
    __device__ __forceinline__ void operator()(EPI_ARGS) const {
        const int row0 = u.pm * BM + wr * 64 + fr;
#pragma unroll
        EPI_ROWS { const size_t row = (size_t)(row0 + ai * HALF + m * 16);
#pragma unroll
            for (int bj = 0; bj < 2; ++bj) { const int grp = 8 * u.pn + 4 * bj + wc; const f32x4 g = acc[ai][bj][m][0], up = acc[ai][bj][m][1]; f32x4 o;
#pragma unroll
                for (int e = 0; e < 4; ++e) o[e] = g[e] * sigmoidf_(g[e]) * up[e];
                *(u32x2*)(ACT + row * DFF + 16 * grp + 4 * fq) = pk4(o); } }
    }
};
struct EpiDown {
    const float* H1; float* OUT;
    __device__ __forceinline__ void operator()(EPI_ARGS) const {
        const int row0 = u.pm * BM + wr * 64 + fr, col0 = u.pn * BM + wc * 32 + 4 * fq;
#pragma unroll
        EPI_ROWS { const size_t row = (size_t)(row0 + ai * HALF + m * 16);
#pragma unroll
            EPI_COLS { const int col = col0 + bj * HALF + n * 16; *(f32x4*)(OUT + row * DM + col) = *(const f32x4*)(H1 + row * DM + col) * ALPHA + acc[ai][bj][m][n]; } }
    }
};
}

namespace mla {
constexpr int NW = 8, QBLK = 32, KVBLK = 64;
constexpr float SCALE = 0.07216878364870322f;
constexpr float THR = 8.f;
constexpr int LDQ = 1536, LDKN = 1024, LDKR = 64, LDV = 1024, LDO = 1024;
constexpr int SHM_V = 64 * 128 * 2, SHM_K = 64 * 192 * 2;
#define KSWZ(row, colB) ((row) * 384 + ((colB) ^ (((row) & 7) << 4)))
#define SBAR() __builtin_amdgcn_sched_barrier(0)
__device__ __forceinline__ int crow(int r, int hi) { return (r & 3) + 8 * (r >> 2) + 4 * hi; }
__device__ __forceinline__ unsigned cvtpk(float lo, float hi) { unsigned r; asm volatile("v_cvt_pk_bf16_f32 %0, %1, %2" : "=v"(r) : "v"(lo), "v"(hi)); return r; }

__device__ __forceinline__ void partialSM(f32x16& p0, f32x16& p1, float& m_reg, float& mn, float& alpha) {
    constexpr float C = SCALE * 1.4426950408889634f;
    float pmax = p0[0];
#pragma unroll
    for (int r = 1; r < 16; ++r) pmax = fmaxf(pmax, p0[r]);
#pragma unroll
    for (int r = 0; r < 16; ++r) pmax = fmaxf(pmax, p1[r]);
    { auto rr = __builtin_amdgcn_permlane32_swap(__float_as_uint(pmax), __float_as_uint(pmax), false, false);
      pmax = fmaxf(__uint_as_float(rr[0]), __uint_as_float(rr[1])); }
    if (__builtin_expect(__all(pmax - m_reg <= THR / SCALE), 1)) { mn = m_reg; alpha = 1.f; }
    else { mn = fmaxf(m_reg, pmax); alpha = __builtin_amdgcn_exp2f((m_reg - mn) * C); m_reg = mn; }
    float mnC = -mn * C;
#pragma unroll
    for (int r = 0; r < 16; ++r) p0[r] = fmaf(p0[r], C, mnC);
#pragma unroll
    for (int r = 0; r < 16; ++r) p1[r] = fmaf(p1[r], C, mnC);
#pragma unroll
    for (int r = 0; r < 16; ++r) p0[r] = __builtin_amdgcn_exp2f(p0[r]);
}
__device__ __forceinline__ void finishSM(f32x16& p0, f32x16& p1, float alpha, float& l_reg, bf16x8& pa0, bf16x8& pa1, bf16x8& pa2, bf16x8& pa3) {
#pragma unroll
    for (int r = 0; r < 16; ++r) p1[r] = __builtin_amdgcn_exp2f(p1[r]);
    float ps = 0;
#pragma unroll
    for (int r = 0; r < 16; ++r) ps += p0[r];
#pragma unroll
    for (int r = 0; r < 16; ++r) ps += p1[r];
    { auto rr = __builtin_amdgcn_permlane32_swap(__float_as_uint(ps), __float_as_uint(ps), false, false);
      ps = __uint_as_float(rr[0]) + __uint_as_float(rr[1]); }
    l_reg = l_reg * alpha + ps;
#define PK4(P, BASE, OUT) do { unsigned a0 = cvtpk(P[BASE + 0], P[BASE + 1]), a1 = cvtpk(P[BASE + 2], P[BASE + 3]);   \
    unsigned b0 = cvtpk(P[BASE + 4], P[BASE + 5]), b1 = cvtpk(P[BASE + 6], P[BASE + 7]);                              \
    auto r0 = __builtin_amdgcn_permlane32_swap(a0, b0, false, false); auto r1 = __builtin_amdgcn_permlane32_swap(a1, b1, false, false); \
    u32x4 w = {r0[0], r1[0], r0[1], r1[1]}; OUT = *reinterpret_cast<bf16x8*>(&w); } while (0)
    PK4(p0, 0, pa0); PK4(p0, 8, pa1); PK4(p1, 0, pa2); PK4(p1, 8, pa3);
#undef PK4
}
__device__ __forceinline__ void qkt(f32x16& p0, f32x16& p1, const char* Ks, const bf16x8* qr, int r32, int hi) {
    p0 = f32x16{}; p1 = f32x16{};
#pragma unroll
    for (int d0 = 0; d0 < 12; ++d0) { int cb = (d0 * 16 + hi * 8) * 2;
        bf16x8 b0 = *reinterpret_cast<const bf16x8*>(Ks + KSWZ(r32, cb));
        bf16x8 b1 = *reinterpret_cast<const bf16x8*>(Ks + KSWZ(32 + r32, cb));
        p0 = __builtin_amdgcn_mfma_f32_32x32x16_bf16(b0, qr[d0], p0, 0, 0, 0);
        p1 = __builtin_amdgcn_mfma_f32_32x32x16_bf16(b1, qr[d0], p1, 0, 0, 0); }
}
__device__ __forceinline__ int v_st(int k, int c) { const int kk = (k & ~0xC) | ((k & 4) << 1) | ((k & 8) >> 1); return ((kk >> 3) * 4 + (c >> 5)) * 512 + ((kk & 7) * 32 + (c & 31)) * 2; }
__device__ __forceinline__ int v_rd_base(int lane) { return ((lane & 3) << 3) | (((lane >> 2) & 3) << 6) | (((lane >> 4) & 1) << 5) | (((lane >> 5) & 1) << 8); }
constexpr int v_rd_off(int d0, int ks, int half) { return d0 * 512 + ks * 4096 + half * 2048; }
template <int OFF> __device__ __forceinline__ s16x4 tr_read(int vb) {
    s16x4 r; asm volatile("ds_read_b64_tr_b16 %0, %1 offset:%2" : "=&v"(r) : "v"(vb), "i"(OFF) : "memory"); return r;
}
template <int D0> __device__ __forceinline__ void pv_one(f32x16& od, int vb, bf16x8 pa0, bf16x8 pa1, bf16x8 pa2, bf16x8 pa3) {
    const s16x4 l0 = tr_read<v_rd_off(D0, 0, 0)>(vb), h0 = tr_read<v_rd_off(D0, 0, 1)>(vb), l1 = tr_read<v_rd_off(D0, 1, 0)>(vb), h1 = tr_read<v_rd_off(D0, 1, 1)>(vb);
    const s16x4 l2 = tr_read<v_rd_off(D0, 2, 0)>(vb), h2 = tr_read<v_rd_off(D0, 2, 1)>(vb), l3 = tr_read<v_rd_off(D0, 3, 0)>(vb), h3 = tr_read<v_rd_off(D0, 3, 1)>(vb);
    asm volatile("s_waitcnt lgkmcnt(0)" ::: "memory"); SBAR();
#define PK(L, H) (bf16x8){L[0], L[1], L[2], L[3], H[0], H[1], H[2], H[3]}
    od = __builtin_amdgcn_mfma_f32_32x32x16_bf16(pa0, PK(l0, h0), od, 0, 0, 0);
    od = __builtin_amdgcn_mfma_f32_32x32x16_bf16(pa1, PK(l1, h1), od, 0, 0, 0);
    od = __builtin_amdgcn_mfma_f32_32x32x16_bf16(pa2, PK(l2, h2), od, 0, 0, 0);
    od = __builtin_amdgcn_mfma_f32_32x32x16_bf16(pa3, PK(l3, h3), od, 0, 0, 0);
#undef PK
}
__device__ __forceinline__ void pv_d0(f32x16* o, int vb, bf16x8 pa0, bf16x8 pa1, bf16x8 pa2, bf16x8 pa3) {
    pv_one<0>(o[0], vb, pa0, pa1, pa2, pa3); pv_one<1>(o[1], vb, pa0, pa1, pa2, pa3); pv_one<2>(o[2], vb, pa0, pa1, pa2, pa3); pv_one<3>(o[3], vb, pa0, pa1, pa2, pa3);
}

__device__ __forceinline__ void attn_unit(const bf16_t* __restrict__ Qb, const bf16_t* __restrict__ Kn, const bf16_t* __restrict__ Kr, const bf16_t* __restrict__ Vh,
                                          bf16_t* __restrict__ Ob, int seq, char* lds) {
    const int tid = threadIdx.x, wid = tid >> 6, lane = tid & 63, r32 = lane & 31, hi = lane >> 5;
    char* V_lds = lds; char* K_lds = lds + 2 * SHM_V;
    float* ws = (float*)(lds + 2 * SHM_V + 2 * SHM_K) + wid * 64; float* li_l = ws; float* al_l = ws + 32;
    float m_reg = -1e30f, l_reg = 0; f32x16 o[4] = {}; bf16x8 qr[12];
    const bf16_t* Qw = Qb + (long)(wid * QBLK + r32) * LDQ + hi * 8;
#pragma unroll
    for (int d0 = 0; d0 < 12; ++d0) qr[d0] = *reinterpret_cast<const bf16x8*>(Qw + d0 * 16);
    const int sr = tid >> 4, sc = (tid & 15) * 8, vst0 = v_st(sr, sc), vst1 = v_st(32 + sr, sc);
    const int vb0 = (int)(uintptr_t)V_lds + v_rd_base(lane);
    const bf16_t* kp[3]; int kstr[3], kst[3];
#pragma unroll
    for (int i = 0; i < 3; ++i) { const int q = tid + 512 * i, row = q / 24, cc = q % 24;
        kp[i] = (cc < 16) ? (Kn + (long)row * LDKN + cc * 8) : (Kr + (long)row * LDKR + (cc - 16) * 8); kstr[i] = (cc < 16) ? LDKN : LDKR; kst[i] = KSWZ(row, cc * 16); }
    bf16x8 vs0, vs1, ks0, ks1, ks2;
#define SLOAD(k0) do { vs0 = *reinterpret_cast<const bf16x8*>(&Vh[(long)((k0) + sr) * LDV + sc]); vs1 = *reinterpret_cast<const bf16x8*>(&Vh[(long)((k0) + 32 + sr) * LDV + sc]); \
    ks0 = *reinterpret_cast<const bf16x8*>(kp[0] + (long)(k0) * kstr[0]); ks1 = *reinterpret_cast<const bf16x8*>(kp[1] + (long)(k0) * kstr[1]); ks2 = *reinterpret_cast<const bf16x8*>(kp[2] + (long)(k0) * kstr[2]); } while (0)
#define SWRITE(b) do { *(bf16x8*)(V_lds + (b) * SHM_V + vst0) = vs0; *(bf16x8*)(V_lds + (b) * SHM_V + vst1) = vs1; \
    *(bf16x8*)(K_lds + (b) * SHM_K + kst[0]) = ks0; *(bf16x8*)(K_lds + (b) * SHM_K + kst[1]) = ks1; *(bf16x8*)(K_lds + (b) * SHM_K + kst[2]) = ks2; } while (0)
#define SWAIT() asm volatile("s_waitcnt vmcnt(0)" ::: "memory")
#define RESC(a) do { if (__any((a) < 1.f)) { if (hi == 0) al_l[r32] = (a); asm volatile("s_waitcnt lgkmcnt(0)" ::: "memory"); \
    _Pragma("unroll") for (int d = 0; d < 4; ++d) _Pragma("unroll") for (int r = 0; r < 16; ++r) o[d][r] *= al_l[crow(r, hi)]; } } while (0)
    f32x16 pA0, pA1; float mnA, alA; bf16x8 pa0, pa1, pa2, pa3; const int NT = seq / KVBLK;
    SLOAD(0); SWAIT(); SWRITE(0); __syncthreads();
#pragma unroll 1
    for (int j = 0; j < NT; ++j) {
        const int buf = j & 1;
        if (j + 1 < NT) SLOAD((j + 1) * KVBLK);
        SBAR(); qkt(pA0, pA1, K_lds + buf * SHM_K, qr, r32, hi);
        partialSM(pA0, pA1, m_reg, mnA, alA);
        RESC(alA);
        finishSM(pA0, pA1, alA, l_reg, pa0, pa1, pa2, pa3); SBAR();
        pv_d0(o, vb0 + buf * (int)SHM_V, pa0, pa1, pa2, pa3);
        if (j + 1 < NT) { SWAIT(); SWRITE(buf ^ 1); }
        __syncthreads();
    }
    if (hi == 0) li_l[r32] = l_reg; asm volatile("s_waitcnt lgkmcnt(0)" ::: "memory");
    float rli[16];
#pragma unroll
    for (int r = 0; r < 16; ++r) rli[r] = __builtin_amdgcn_rcpf(li_l[crow(r, hi)]);
    bf16_t* Ow = Ob + (long)(wid * QBLK) * LDO;
#pragma unroll
    for (int r = 0; r < 16; ++r) { int orow = crow(r, hi);
#pragma unroll
        for (int d0 = 0; d0 < 4; ++d0) Ow[(long)orow * LDO + d0 * 32 + r32] = (bf16_t)f2bf(o[d0][r] * rli[r]); }
    __syncthreads();
#undef SLOAD
#undef SWRITE
#undef SWAIT
#undef RESC
}
#undef SBAR
}

struct Args { const float* in[22]; float* out; unsigned char* ws; int ph_lo, ph_hi; };

__device__ __forceinline__ void tr_item(const float* Wa, int ca, const float* Wb, int cb, int ldw, int k0, bf16_t* WT, int ldt, int drow0, const float* ksc, float* scr, int lane) {
    const int n = lane & 31;
    const float* src = (n < 16) ? (Wa + ca + n) : (Wb + cb + (n - 16));
#pragma unroll 8
    for (int i = 0; i < 32; ++i) { const int kk = 2 * i + (lane >> 5); float v = 0.f; if (Wa) v = src[(size_t)(k0 + kk) * ldw]; if (ksc) v *= ksc[k0 + kk]; scr[kk * 33 + n] = v; }
    LDS_WAIT();
    const int c = lane & 7;
#pragma unroll
    for (int j = 0; j < 4; ++j) { const int nn = (lane >> 3) + 8 * j; const float* s = scr + (8 * c) * 33 + nn;
        u32x4 o; o.x = pk2(s[0 * 33], s[1 * 33]); o.y = pk2(s[2 * 33], s[3 * 33]); o.z = pk2(s[4 * 33], s[5 * 33]); o.w = pk2(s[6 * 33], s[7 * 33]);
        *(u32x4*)(WT + (size_t)(drow0 + nn) * ldt + k0 + 8 * c) = o; }
    LDS_WAIT();
}
__device__ __forceinline__ void tr_plain(const float* W, int K, int N, bf16_t* WT, const float* ksc, float* scr, int lane, int gw, int NGW) {
    const int nkb = K / 64, nit = nkb * (N / 32);
    for (int it = gw; it < nit; it += NGW) { const int grp = it / nkb, kb = it % nkb; tr_item(W, 32 * grp, W, 32 * grp + 16, N, 64 * kb, WT, K, 32 * grp, ksc, scr, lane); }
}
__device__ __forceinline__ void ln_row(const float* xrow, const float* g, const float* b, float* of, bf16_t* ob, float* stats, int lane) {
    const f32x4* xr = (const f32x4*)xrow + lane;
    f32x4 v[8]; float s = 0.f;
#pragma unroll
    for (int j = 0; j < 8; ++j) { v[j] = xr[64 * j]; s += (v[j][0] + v[j][1]) + (v[j][2] + v[j][3]); }
    const float mean = wave_sum(s) * (1.f / DM); float s2 = 0.f;
#pragma unroll
    for (int j = 0; j < 8; ++j) { v[j] = v[j] - mean; s2 += (v[j][0] * v[j][0] + v[j][1] * v[j][1]) + (v[j][2] * v[j][2] + v[j][3] * v[j][3]); }
    const float rstd = rsqrtf(wave_sum(s2) * (1.f / DM) + LN_EPS);
    if (stats && lane == 0) { stats[0] = mean; stats[1] = rstd; }
#pragma unroll
    for (int j = 0; j < 8; ++j) { const f32x4 gv = ((const f32x4*)g)[64 * j + lane], bv = ((const f32x4*)b)[64 * j + lane]; const f32x4 y = v[j] * rstd * gv + bv;
        if (of) ((f32x4*)of)[64 * j + lane] = y;
        if (ob) ((u32x2*)ob)[64 * j + lane] = pk4(y); }
}

__global__ void __launch_bounds__(512) mega(Args a) {
    extern __shared__ __attribute__((aligned(16))) unsigned char lds[];
    cg::grid_group grid = cg::this_grid();
    const int tid = threadIdx.x, lane = tid & 63, wave = __builtin_amdgcn_readfirstlane(tid >> 6);
    const int G = gridDim.x, bid = blockIdx.x;
    const int gw = bid * 8 + wave, NGW = G * 8;
    unsigned char* ws = a.ws;
    LAS unsigned char* ldsl = (LAS unsigned char*)lds;
    const float* x = a.in[0]; const float* memp = a.in[1]; const int* positions = (const int*)a.in[2];
    const float *ln_emb_g = a.in[3], *ln_emb_b = a.in[4], *lb_logits = a.in[5], *w_in = a.in[6], *hg_norm_g = a.in[7], *g_cq = a.in[8], *g_ckv = a.in[9];
    const float *w_uq = a.in[10], *w_ukv = a.in[11], *w_kvm = a.in[12], *w_branch = a.in[13], *w_o = a.in[14], *ln1_g = a.in[15], *ln1_b = a.in[16];
    const float *w_gate = a.in[17], *w_up = a.in[18], *w_down = a.in[19], *ln2_g = a.in[20], *ln2_b = a.in[21];
    float* out = a.out;
#define WSP(T, off) ((T*)(ws + (off)))
    float* SSQ = WSP(float, WS_SSQ); float* STATS = WSP(float, WS_STATS); float* LB = WSP(float, WS_LB);
    float* COS = WSP(float, WS_COS); float* SIN = WSP(float, WS_SIN); float* DVEC = WSP(float, WS_DVEC);
    bf16_t *WIN_T = WSP(bf16_t, WS_WIN_T), *H0B = WSP(bf16_t, WS_H0B), *WUQ_T = WSP(bf16_t, WS_WUQ_T), *WUKV_T = WSP(bf16_t, WS_WUKV_T), *WKV_T = WSP(bf16_t, WS_WKV_T), *MEMB = WSP(bf16_t, WS_MEMB);
    bf16_t *KVM = WSP(bf16_t, WS_KVM), *VMT = WSP(bf16_t, WS_VMT), *KR = WSP(bf16_t, WS_KR);
    bf16_t *QH = WSP(bf16_t, WS_QH), *VH = WSP(bf16_t, WS_VH), *GF = WSP(bf16_t, WS_GF), *GH = WSP(bf16_t, WS_GH), *CQ = WSP(bf16_t, WS_CQ), *CKV = WSP(bf16_t, WS_CKV), *QM = WSP(bf16_t, WS_QM), *GS = WSP(bf16_t, WS_GS);
    bf16_t *HS = WSP(bf16_t, WS_HS), *YA = WSP(bf16_t, WS_YA), *WBR_T = WSP(bf16_t, WS_WBR_T), *WO_T = WSP(bf16_t, WS_WO_T);
    bf16_t *KB = WSP(bf16_t, WS_KB), *VB = WSP(bf16_t, WS_VB), *QB = WSP(bf16_t, WS_QB), *SC = WSP(bf16_t, WS_SC), *PM = WSP(bf16_t, WS_PM), *YH = WSP(bf16_t, WS_YH), *YM = WSP(bf16_t, WS_YM);
    float* MERGED = WSP(float, WS_MERGED); bf16_t* MERGEDB = WSP(bf16_t, WS_MERGEDB); float* R1 = WSP(float, WS_R1); bf16_t* H1B = WSP(bf16_t, WS_H1B);
    bf16_t *WGU_T = WSP(bf16_t, WS_WGU_T), *WD_T = WSP(bf16_t, WS_WD_T), *ACT = WSP(bf16_t, WS_ACT);

#ifndef PHMASK
#define PHMASK 0x7ff
#endif
#define IN(k) (((PHMASK >> (k)) & 1) && a.ph_lo <= (k) && (k) < a.ph_hi)
#define SEAM(k) do { if (IN(k) && IN((k) + 1)) { asm volatile("s_waitcnt vmcnt(0)" ::: "memory"); __threadfence(); grid.sync(); __builtin_amdgcn_fence(__ATOMIC_ACQUIRE, "agent"); asm volatile("s_waitcnt vmcnt(0)" ::: "memory"); } } while (0)

    if (IN(0)) {
        float* scr = (float*)lds + wave * (64 * 33);
        {
            const int nit = 32 * (NINP / 32);
            for (int it = gw; it < nit; it += NGW) { const int grp = it / 32, kb = it % 32, n0 = 32 * grp; const float* Wa = w_in; int ca, cb;
                if (n0 < 6144) { ca = n0; cb = n0 + 16; } else if (n0 < 13312) { ca = n0 + 64; cb = ca + 16; }
                else if (n0 < 13376) { const int g = (n0 - 13312) / 32; ca = 6144 + 16 * g; cb = 6144 + 32 + 16 * g; } else { Wa = nullptr; ca = 0; cb = 0; }
                tr_item(Wa, ca, w_in, cb, 13376, 64 * kb, WIN_T, DM, n0, nullptr, scr, lane); }
        }
        {
            const int nit = 8 * 48;
            for (int it = gw; it < nit; it += NGW) { const int grp = it / 8, kb = it % 8, part = grp % 6, h = grp / 6; int ca, cb;
                if (part < 4) { ca = 32 * grp; cb = ca + 16; } else { ca = 192 * h + 128 + 16 * (part - 4); cb = ca + 32; }
                tr_item(w_uq, ca, w_uq, cb, 1536, 64 * kb, WUQ_T, 512, 32 * grp, g_cq, scr, lane); }
        }
        tr_plain(w_ukv, 512, 2048, WUKV_T, g_ckv, scr, lane, gw, NGW);
        tr_plain(w_kvm, 2048, 2048, WKV_T, nullptr, scr, lane, gw, NGW);
        for (int z = 0; z < 3; ++z) tr_plain(w_branch + (size_t)((3 - z) % 3) * 1024 * 2048, 1024, 2048, WBR_T + (size_t)z * 2048 * 1024, nullptr, scr, lane, gw, NGW);
        tr_plain(w_o, 2048, 2048, WO_T, nullptr, scr, lane, gw, NGW);
        for (int m = gw; m < S; m += NGW) ln_row(x + (size_t)m * DM, ln_emb_g, ln_emb_b, nullptr, H0B + (size_t)m * DM, STATS + 2 * m, lane);
        const int gt = bid * 512 + tid, NGT = G * 512;
        for (int i = gt; i < S * 32; i += NGT) { const int s = i >> 5, f = i & 31;
            const double invf = exp(-(double)f * (9.210340371976184 / 32.0));
            const double t = (double)positions[s] * invf * 0.15915494309189535; const float fr = (float)(t - rint(t));
            COS[i] = __builtin_amdgcn_cosf(fr); SIN[i] = __builtin_amdgcn_sinf(fr); }
        for (int i = gt; i < 2048; i += NGT) { const int z = i >> 10, w = i & 1023; const float l0 = lb_logits[(z * 2 + 0) * 1024 + w], l1 = lb_logits[(z * 2 + 1) * 1024 + w]; LB[i] = 1.f / (1.f + __expf(l1 - l0)); }
        for (int i = gt; i < NMEM * DM / 4; i += NGT) ((u32x2*)MEMB)[i] = pk4(((const f32x4*)memp)[i]);
        __syncthreads();
    }
    SEAM(0);
    if (IN(1)) {
        {   pg8::Sched Sc; Sc.init(S, NINP, 1, G, bid); Sc.a_z = 0; Sc.A0 = (const char*)H0B; Sc.B = (const char*)WIN_T; Sc.a_pm = 256L * DM * 2; Sc.a_pn = 0; Sc.b_pn = 256L * DM * 2; Sc.b_z = 0;
            pg8::EpiP1 E{QH, VH, GF, GH, CQ, CKV, QM, GS, KR, SSQ, LB, COS, SIN};
            pg8::gemm_phase<pg8::EpiP1, true>(ldsl, DM, DM, DM, Sc, E); }
        {
            pg8::Sched Sc; Sc.init(NMEM, 1024, 1, G, bid); Sc.a_z = 0; Sc.A0 = (const char*)MEMB; Sc.B = (const char*)WKV_T; Sc.a_pm = 0; Sc.a_pn = 0; Sc.b_pn = 256L * DM * 2; Sc.b_z = 0;
            pg8::EpiStore E{KVM, 1024, 1.f};
            pg8::gemm_phase<pg8::EpiStore, true>(ldsl, DM, DM, DM, Sc, E); }
        {
            pg8::Sched Sc; Sc.init(1024, NMEM, 1, G, bid); Sc.a_z = 0; Sc.A0 = (const char*)(WKV_T + (size_t)1024 * DM); Sc.B = (const char*)MEMB; Sc.a_pm = 256L * DM * 2; Sc.a_pn = 0; Sc.b_pn = 0; Sc.b_z = 0;
            pg8::EpiStore E{VMT, 256, 1.f};
            pg8::gemm_phase<pg8::EpiStore, true>(ldsl, DM, DM, DM, Sc, E); }
    }
    SEAM(1);
    if (IN(2)) {
#ifndef DBG_SKIPG2
        {   pg8::Sched Sc; Sc.init(S, 1536, 1, G, bid); Sc.a_z = 0; Sc.A0 = (const char*)CQ; Sc.B = (const char*)WUQ_T; Sc.a_pm = 256L * 512 * 2; Sc.a_pn = 0; Sc.b_pn = 256L * 512 * 2; Sc.b_z = 0;
            pg8::EpiQ E{QB, SSQ, COS, SIN};
            pg8::gemm_phase<pg8::EpiQ, true>(ldsl, 512, 512, 512, Sc, E); }
        {   pg8::Sched Sc; Sc.init(S, 2048, 1, G, bid); Sc.a_z = 0; Sc.A0 = (const char*)CKV; Sc.B = (const char*)WUKV_T; Sc.a_pm = 256L * 512 * 2; Sc.a_pn = 0; Sc.b_pn = 256L * 512 * 2; Sc.b_z = 0;
            pg8::EpiKV E{KB, VB, SSQ + (size_t)S * 8};
            pg8::gemm_phase<pg8::EpiKV, true>(ldsl, 512, 512, 512, Sc, E); }
        {
            pg8::Sched Sc; Sc.init(S, 1024, 1, G, bid); Sc.a_z = 0; Sc.A0 = (const char*)QM; Sc.B = (const char*)KVM; Sc.a_pm = 256L * 1024 * 2; Sc.a_pn = 256 * 2; Sc.b_pn = 256 * 2; Sc.b_z = 0;
            pg8::EpiStore E{SC, 1024, 0.0625f};
            pg8::gemm_phase<pg8::EpiStore, true>(ldsl, 1024, 1024, 256, Sc, E); }
#endif
#ifdef DBG_COPY
        { const size_t gt2 = (size_t)bid * 512 + tid, NGT2 = (size_t)G * 512;
          for (size_t j = gt2; j < 16777216; j += NGT2) { HS[j] = GF[j]; HS[16777216 + j] = VH[j & 8388607]; }
          for (size_t j = gt2; j < 262144; j += NGT2) DVEC[j] = 1.f; }
#else
        {
            bf16_t* KwT = (bf16_t*)lds;
            bf16_t* VT = (bf16_t*)(lds + 18432);
            float* TOT = (float*)(lds + 36864);
            const int ch = tid & 127, sb = tid >> 7;
            for (int it = bid; it < 2048; it += G) {
                const int z = it >> 10, h = (it >> 7) & 7, c = it & 127, t0 = 64 * c;
                __syncthreads();
                float gr[16], ar[16]; float acc_a = 0.f;
#pragma unroll
                for (int r = 0; r < 16; ++r) { const int tau = 16 * sb + r, t = z ? (t0 + 63 - tau) : (t0 + tau);
                    const float g = bf2f(GF[(size_t)z * S * 1024 + (size_t)t * 1024 + 128 * h + ch]); acc_a += g; gr[r] = g; ar[r] = acc_a; }
                TOT[sb * 128 + ch] = acc_a;
#pragma unroll
                for (int j = 0; j < 2; ++j) { const int q = tid + 512 * j, tau = q >> 4, vc0 = (q & 15) * 8, t = z ? (t0 + 63 - tau) : (t0 + tau);
                    const bf16x8 v = *(const bf16x8*)(VH + (size_t)t * 1024 + 128 * h + vc0);
#pragma unroll
                    for (int e = 0; e < 8; ++e) VT[(vc0 + e) * 72 + tau] = (bf16_t)v[e]; }
                __syncthreads();
                float later = 0.f;
#pragma unroll
                for (int i2 = 1; i2 < 4; ++i2) if (i2 > sb) later += TOT[i2 * 128 + ch];
                if (sb == 0) DVEC[(size_t)it * 128 + ch] = __expf(acc_a + later);
#pragma unroll
                for (int r = 0; r < 16; ++r) { const float k = 1.f - __expf(gr[r]); KwT[ch * 72 + 16 * sb + r] = (bf16_t)f2bf(k * __expf((acc_a - ar[r]) + later)); }
                __syncthreads();
                f32x4 acc[8];
#pragma unroll
                for (int nb = 0; nb < 8; ++nb) acc[nb] = (f32x4){0.f, 0.f, 0.f, 0.f};
#pragma unroll
                for (int ks = 0; ks < 2; ++ks) { const bf16x8 A = *(const bf16x8*)(KwT + (16 * wave + (lane & 15)) * 72 + 32 * ks + (lane >> 4) * 8);
#pragma unroll
                    for (int nb = 0; nb < 8; ++nb) { const bf16x8 Bv = *(const bf16x8*)(VT + (16 * nb + (lane & 15)) * 72 + 32 * ks + (lane >> 4) * 8);
                        acc[nb] = __builtin_amdgcn_mfma_f32_16x16x32_bf16(A, Bv, acc[nb], 0, 0, 0); } }
                bf16_t* hs = HS + (size_t)it * 16384;
#pragma unroll
                for (int nb = 0; nb < 8; ++nb) *(u32x2*)(hs + (16 * nb + (lane & 15)) * 128 + 16 * wave + (lane >> 4) * 4) = pk4(acc[nb]);
            }
            __syncthreads();
        }
#endif
    }
    SEAM(2);
    if (IN(3)) {
        {
            const int gt = bid * 512 + tid, NGT = G * 512;
            for (int p = gt; p < 16 * 8192; p += NGT) { const int zh = p >> 13, e2 = p & 8191, z = zh >> 3, kch = (2 * e2) & 127;
                float s0 = 0.f, s1 = 0.f;
#pragma unroll 4
                for (int n = 0; n < 128; ++n) { const int c = z ? (127 - n) : n; const size_t it = (size_t)zh * 128 + c;
                    unsigned* pp = (unsigned*)(HS + it * 16384 + 2 * e2); const unsigned uu = *pp; const float d0 = DVEC[it * 128 + kch], d1 = DVEC[it * 128 + kch + 1];
                    *pp = cvt_pk_bf16(s0, s1);
                    s0 = d0 * s0 + __uint_as_float(uu << 16); s1 = d1 * s1 + __uint_as_float(uu & 0xffff0000u); } }
        }
        {
            for (int r = gw; r < S * 4; r += NGW) { const u32x2 w = *(const u32x2*)(SC + (size_t)r * 256 + 4 * lane); f32x4 v = unpk4(w);
                const float mx = wave_max(fmaxf(fmaxf(v[0], v[1]), fmaxf(v[2], v[3])));
#pragma unroll
                for (int e = 0; e < 4; ++e) v[e] = __expf(v[e] - mx);
                const float sm = wave_sum((v[0] + v[1]) + (v[2] + v[3])); const float inv = 1.f / sm;
                *(u32x2*)(PM + (size_t)r * 256 + 4 * lane) = pk4(v * inv); }
        }
        __syncthreads();
        for (int un = bid; un < 256; un += G) { const int h = un & 7, qb = un >> 3;
            mla::attn_unit(QB + (size_t)qb * 256 * 1536 + 192 * h, KB + 128 * h, KR, VB + 128 * h, YA + (size_t)qb * 256 * 1024 + 128 * h, S, (char*)lds); }
    }
    SEAM(3);
    if (IN(4)) {
        {   pg8::Sched Sc; Sc.init(S, 1024, 1, G, bid); Sc.a_z = 0; Sc.A0 = (const char*)PM; Sc.B = (const char*)VMT; Sc.a_pm = 256L * 1024 * 2; Sc.a_pn = 256 * 2; Sc.b_pn = 256L * 256 * 2; Sc.b_z = 0;
            pg8::EpiStore E{YM, 1024, 1.f};
            pg8::gemm_phase<pg8::EpiStore, true>(ldsl, 1024, 256, 256, Sc, E); }
        {
            bf16_t* QT = (bf16_t*)lds;
            bf16_t* KBt = (bf16_t*)(lds + 17408);
            bf16_t* KHT = (bf16_t*)(lds + 34816);
            bf16_t* VT = (bf16_t*)(lds + 53248);
            bf16_t* ST = (bf16_t*)(lds + 71680);
            float* O = (float*)(lds + 106496);
            float* Dd = (float*)(lds + 139264);
            bf16_t* PW = (bf16_t*)(lds + 141312) + wave * 256;
            const int ch = tid & 127, sb = tid >> 7, l15 = lane & 15, l4 = lane >> 4;
            for (int it = bid; it < 1024; it += G) {
                const int h = it >> 7, c = it & 127, t0 = 64 * c;
#pragma unroll 1
                for (int z = 0; z < 2; ++z) {
                    __syncthreads();
                    {   float gr[16], ar[16]; float aa = 0.f;
#pragma unroll
                        for (int r = 0; r < 16; ++r) { const int tau = 16 * sb + r, t = z ? (t0 + 63 - tau) : (t0 + tau);
                            const float g = bf2f(GF[(size_t)z * S * 1024 + (size_t)t * 1024 + 128 * h + ch]); aa += g; gr[r] = g; ar[r] = aa; }
                        Dd[sb * 128 + ch] = __expf(aa);
#pragma unroll
                        for (int r = 0; r < 16; ++r) { const int tau = 16 * sb + r, t = z ? (t0 + 63 - tau) : (t0 + tau);
                            const float q = bf2f(QH[(size_t)t * 1024 + 128 * h + ch]); const float k = 1.f - __expf(gr[r]);
                            QT[tau * 136 + ch] = (bf16_t)f2bf(q * __expf(ar[r])); KBt[tau * 136 + ch] = (bf16_t)f2bf(k * __expf(-ar[r])); KHT[ch * 72 + tau] = (bf16_t)f2bf(k * __expf(aa - ar[r])); }
                    }
#pragma unroll
                    for (int j = 0; j < 2; ++j) { const int q = tid + 512 * j, tau = q >> 4, vc0 = (q & 15) * 8, t = z ? (t0 + 63 - tau) : (t0 + tau);
                        const bf16x8 v = *(const bf16x8*)(VH + (size_t)t * 1024 + 128 * h + vc0);
#pragma unroll
                        for (int e = 0; e < 8; ++e) VT[(vc0 + e) * 72 + tau] = (bf16_t)v[e]; }
                    {   const bf16_t* hs = HS + ((size_t)(z * 8 + h) * 128 + c) * 16384;
#pragma unroll
                        for (int j = 0; j < 4; ++j) { const int q = tid + 512 * j, vcol = q >> 4, kc = (q & 15) * 8; *(u32x4*)(ST + vcol * 136 + kc) = *(const u32x4*)(hs + vcol * 128 + kc); } }
                    __syncthreads();
                    f32x4 sacc[8];
#pragma unroll
                    for (int nb = 0; nb < 8; ++nb) { const u32x2 w = *(const u32x2*)(ST + (16 * nb + l15) * 136 + 16 * wave + l4 * 4); sacc[nb] = unpk4(w); }
#pragma unroll 1
                    for (int i = 0; i < 4; ++i) {
                        bf16x8 Aq[4];
#pragma unroll
                        for (int ks = 0; ks < 4; ++ks) Aq[ks] = *(const bf16x8*)(QT + (16 * i + l15) * 136 + 32 * ks + l4 * 8);
                        f32x4 o = (f32x4){0.f, 0.f, 0.f, 0.f}, att = (f32x4){0.f, 0.f, 0.f, 0.f};
#pragma unroll
                        for (int ks = 0; ks < 4; ++ks) { const bf16x8 Bs = *(const bf16x8*)(ST + (16 * wave + l15) * 136 + 32 * ks + l4 * 8); o = __builtin_amdgcn_mfma_f32_16x16x32_bf16(Aq[ks], Bs, o, 0, 0, 0); }
#pragma unroll
                        for (int ks = 0; ks < 4; ++ks) { const bf16x8 Bk = *(const bf16x8*)(KBt + (16 * i + l15) * 136 + 32 * ks + l4 * 8); att = __builtin_amdgcn_mfma_f32_16x16x32_bf16(Aq[ks], Bk, att, 0, 0, 0); }
#pragma unroll
                        for (int j = 0; j < 4; ++j) { const int tr = l4 * 4 + j; PW[tr * 16 + l15] = (bf16_t)f2bf((l15 <= tr) ? att[j] : 0.f); }
                        LDS_WAIT();
                        bf16x8 Ap = (bf16x8){0, 0, 0, 0, 0, 0, 0, 0}, Bv = (bf16x8){0, 0, 0, 0, 0, 0, 0, 0}, Ak = (bf16x8){0, 0, 0, 0, 0, 0, 0, 0};
                        if (lane < 32) { Ap = *(const bf16x8*)(PW + l15 * 16 + l4 * 8); Bv = *(const bf16x8*)(VT + (16 * wave + l15) * 72 + 16 * i + l4 * 8); Ak = *(const bf16x8*)(KHT + (16 * wave + l15) * 72 + 16 * i + l4 * 8); }
                        o = __builtin_amdgcn_mfma_f32_16x16x32_bf16(Ap, Bv, o, 0, 0, 0);
#pragma unroll
                        for (int j = 0; j < 4; ++j) { const int tau = 16 * i + l4 * 4 + j, tt = z ? (63 - tau) : tau; float* op = O + tt * 128 + 16 * wave + l15; if (z == 0) *op = o[j]; else *op += o[j]; }
                        if (i < 3) {
                            const f32x4 dv = *(const f32x4*)(Dd + i * 128 + 16 * wave + l4 * 4);
#pragma unroll
                            for (int nb = 0; nb < 8; ++nb) { bf16x8 Bn = (bf16x8){0, 0, 0, 0, 0, 0, 0, 0}; if (lane < 32) Bn = *(const bf16x8*)(VT + (16 * nb + l15) * 72 + 16 * i + l4 * 8);
                                sacc[nb] = __builtin_amdgcn_mfma_f32_16x16x32_bf16(Ak, Bn, sacc[nb] * dv, 0, 0, 0); }
                            __syncthreads();
#pragma unroll
                            for (int nb = 0; nb < 8; ++nb) *(u32x2*)(ST + (16 * nb + l15) * 136 + 16 * wave + l4 * 4) = pk4(sacc[nb]);
                            __syncthreads();
                        }
                    }
                }
                __syncthreads();
#pragma unroll 1
                for (int k2 = 0; k2 < 8; ++k2) { const int tt = 8 * wave + k2; const float v0 = O[tt * 128 + lane], v1 = O[tt * 128 + 64 + lane];
                    const float r = rsqrtf(wave_sum(v0 * v0 + v1 * v1) * (1.f / 128.f) + RMS_EPS); const size_t base = (size_t)(t0 + tt) * 1024 + 128 * h;
                    YH[base + lane] = (bf16_t)f2bf(v0 * r * hg_norm_g[lane] * bf2f(GH[base + lane]));
                    YH[base + 64 + lane] = (bf16_t)f2bf(v1 * r * hg_norm_g[64 + lane] * bf2f(GH[base + 64 + lane])); }
            }
            __syncthreads();
        }
    }
    SEAM(4);
    if (IN(5)) {
        pg8::Sched Sc; Sc.init(S, DM, 3, G, bid); Sc.A0 = (const char*)YH; Sc.a_z = 16L * 1024 * 1024; Sc.B = (const char*)WBR_T; Sc.a_pm = 256L * 1024 * 2; Sc.a_pn = 0; Sc.b_pn = 256L * 1024 * 2; Sc.b_z = 2048L * 1024 * 2;
        pg8::EpiMerge E{GS, MERGED, MERGEDB};
        pg8::gemm_phase<pg8::EpiMerge, true>(ldsl, 1024, 1024, 1024, Sc, E);
    }
    SEAM(5);
    if (IN(6)) {
        pg8::Sched Sc; Sc.init(S, DM, 1, G, bid); Sc.a_z = 0; Sc.A0 = (const char*)MERGEDB; Sc.B = (const char*)WO_T; Sc.a_pm = 256L * DM * 2; Sc.a_pn = 0; Sc.b_pn = 256L * DM * 2; Sc.b_z = 0;
        pg8::EpiWo E{x, STATS, ln_emb_g, ln_emb_b, R1};
        pg8::gemm_phase<pg8::EpiWo, true>(ldsl, DM, DM, DM, Sc, E);
    }
    SEAM(6);
    if (IN(7)) {
        for (int m = gw; m < S; m += NGW) ln_row(R1 + (size_t)m * DM, ln1_g, ln1_b, R1 + (size_t)m * DM, H1B + (size_t)m * DM, nullptr, lane);
        float* scr = (float*)lds + wave * (64 * 33);
        {   const int nit = 32 * 352;
            for (int it = gw; it < nit; it += NGW) { const int grp = it / 32, kb = it % 32; tr_item(w_gate, 16 * grp, w_up, 16 * grp, DFF, 64 * kb, WGU_T, DM, 32 * grp, nullptr, scr, lane); } }
        tr_plain(w_down, DFF, DM, WD_T, nullptr, scr, lane, gw, NGW);
        __syncthreads();
    }
    SEAM(7);
    if (IN(8)) {
        pg8::Sched Sc; Sc.init(S, 2 * DFF, 1, G, bid); Sc.a_z = 0; Sc.A0 = (const char*)H1B; Sc.B = (const char*)WGU_T; Sc.a_pm = 256L * DM * 2; Sc.a_pn = 0; Sc.b_pn = 256L * DM * 2; Sc.b_z = 0;
        pg8::EpiGU E{ACT};
        pg8::gemm_phase<pg8::EpiGU, true>(ldsl, DM, DM, DM, Sc, E);
    }
    SEAM(8);
    if (IN(9)) {
        pg8::Sched Sc; Sc.init(S, DM, 1, G, bid); Sc.a_z = 0; Sc.A0 = (const char*)ACT; Sc.B = (const char*)WD_T; Sc.a_pm = 256L * DFF * 2; Sc.a_pn = 0; Sc.b_pn = 256L * DFF * 2; Sc.b_z = 0;
        pg8::EpiDown E{R1, out};
        pg8::gemm_phase<pg8::EpiDown, true>(ldsl, DFF, DFF, DFF, Sc, E);
    }
    SEAM(9);
    if (IN(10)) {
        for (int m = gw; m < S; m += NGW) ln_row(out + (size_t)m * DM, ln2_g, ln2_b, out + (size_t)m * DM, nullptr, nullptr, lane);
    }
#ifdef DBG_STOP
    {
        asm volatile("s_waitcnt vmcnt(0)" ::: "memory"); __threadfence(); grid.sync(); __builtin_amdgcn_fence(__ATOMIC_ACQUIRE, "agent"); asm volatile("s_waitcnt vmcnt(0)" ::: "memory");
        const size_t NO = (size_t)S * DM; const size_t gt = (size_t)bid * 512 + tid, NGT = (size_t)G * 512;
#define DB(ptr, n) for (size_t j = i; j < (size_t)(n); j += NO) acc += bf2f(((const bf16_t*)(ptr))[j]);
#define DF(ptr, n) for (size_t j = i; j < (size_t)(n); j += NO) acc += ((const float*)(ptr))[j];
        for (size_t i = gt; i < NO; i += NGT) { float acc = 0.f;
#if DBG_STOP == 0
            DB(WIN_T, 27787264) DB(H0B, 16777216) DB(WUQ_T, 786432) DB(WUKV_T, 1048576) DB(WKV_T, 4194304) DB(MEMB, 524288) DB(WBR_T, 6291456) DB(WO_T, 4194304) DF(STATS, 16384) DF(LB, 2048) DF(COS, 262144) DF(SIN, 262144)
#elif DBG_STOP == 1
            DB(QH, 8388608) DB(VH, 8388608) DB(GF, 16777216) DB(GH, 8388608) DB(CQ, 4194304) DB(CKV, 4194304) DB(QM, 8388608) DB(GS, 50331648) DB(KR, 524288) DB(KVM, 262144) DB(VMT, 262144) DF(SSQ, 131072)
#elif DBG_STOP == 2
            DB(QB, 12582912) DB(KB, 8388608) DB(VB, 8388608) DB(SC, 8388608) DB(HS, 33554432) DF(DVEC, 262144)
#elif DBG_STOP == 3
            DB(HS, 33554432) DB(PM, 8388608) DB(YA, 8388608)
#elif DBG_STOP == 4
            DB(YM, 8388608) DB(YH, 8388608)
#elif DBG_STOP == 5
            DB(MERGEDB, 16777216) DF(MERGED, 16777216)
#elif DBG_STOP == 6
            DF(R1, 16777216)
#elif DBG_STOP == 7
            DF(R1, 16777216) DB(H1B, 16777216) DB(WGU_T, 23068672) DB(WD_T, 11534336)
#elif DBG_STOP == 8
            DB(ACT, 46137344)
#endif
            out[i] = acc; }
    }
#endif
}

extern "C" void kernel_launch(void* const* d_in, const int* in_sizes, int n_in, void* d_out, int out_size, void* d_ws, size_t ws_size, hipStream_t stream) {
    static int grid = 0;
    if (grid == 0) {
        if (n_in != 22 || out_size != S * DM || ws_size < WS_END) { fprintf(stderr, "kernel_launch: unexpected shapes (n_in %d out %d ws %zu, need %zu)\n", n_in, out_size, ws_size, (size_t)WS_END); grid = -1; return; }
        int dev = 0, cus = 0, per_cu = 0;
        hipGetDevice(&dev); hipDeviceGetAttribute(&cus, hipDeviceAttributeMultiprocessorCount, dev);
        if (hipFuncSetAttribute((const void*)mega, hipFuncAttributeMaxDynamicSharedMemorySize, LDS_BYTES) != hipSuccess) { fprintf(stderr, "kernel_launch: hipFuncSetAttribute failed\n"); grid = -1; return; }
        if (hipOccupancyMaxActiveBlocksPerMultiprocessor(&per_cu, (const void*)mega, 512, LDS_BYTES) != hipSuccess || per_cu < 1) { fprintf(stderr, "kernel_launch: occupancy query failed (%d)\n", per_cu); per_cu = 1; (void)hipGetLastError(); }
        grid = cus * 1;
    }
    if (grid < 0) return;
    Args a{};
    for (int i = 0; i < 22; ++i) a.in[i] = (const float*)d_in[i];
    a.out = (float*)d_out; a.ws = (unsigned char*)d_ws; a.ph_lo = 0; a.ph_hi = 11;
#ifdef DBG_STOP
    a.ph_hi = DBG_STOP + 1;
#endif
    void* args[] = {&a};
    hipError_t e = hipLaunchCooperativeKernel((const void*)mega, dim3(grid), dim3(512), args, LDS_BYTES, stream);
    if (e != hipSuccess) fprintf(stderr, "cooperative launch failed: %s (grid %d)\n", hipGetErrorString(e), grid);
}
```

```cpp
#include <hip/hip_runtime.h>
#include <hip/hip_cooperative_groups.h>
#include <cstdio>
#include <cstdint>
namespace cg = cooperative_groups;

#define LAS __attribute__((address_space(3)))
typedef unsigned short bf16_t;
typedef short bf16x8 __attribute__((ext_vector_type(8)));
typedef short s16x4 __attribute__((ext_vector_type(4)));
typedef float f32x4 __attribute__((ext_vector_type(4)));
typedef float f32x16 __attribute__((ext_vector_type(16)));
typedef unsigned u32x4 __attribute__((ext_vector_type(4)));
typedef unsigned u32x2 __attribute__((ext_vector_type(2)));

constexpr int S = 8192, DM = 2048, NMEM = 256, DFF = 5632;
constexpr int LDACT = 5696;
constexpr int NINP = 13568;
constexpr float ALPHA = 1.189207115002721f;
constexpr float LN_EPS = 1e-5f, RMS_EPS = 1e-6f;

constexpr size_t MiB = 1u << 20;
constexpr size_t WS_SSQ = 262144, WS_STATS = 65536, WS_LB = 131072;
constexpr size_t WS_COS = 1 * MiB, WS_SIN = 2 * MiB, WS_DVEC = 3 * MiB;
constexpr size_t WS_WIN_T = 4 * MiB, WS_H0B = 57 * MiB;
constexpr size_t WS_WUQ_T = 89 * MiB, WS_WUKV_T = 89 * MiB + 1536 * 1024, WS_WKV_T = 92 * MiB + 512 * 1024, WS_MEMB = 100 * MiB + 512 * 1024;
constexpr size_t WS_KVM = 102 * MiB, WS_VMT = 102 * MiB + 512 * 1024, WS_KR = 103 * MiB;
constexpr size_t WS_QH = 104 * MiB, WS_VH = 120 * MiB, WS_GF = 136 * MiB, WS_GH = 168 * MiB;
constexpr size_t WS_CQ = 184 * MiB, WS_CKV = 192 * MiB, WS_QM = 200 * MiB, WS_GS = 216 * MiB;
constexpr size_t WS_HS = 312 * MiB, WS_YA = 84 * MiB, WS_WBR_T = 393 * MiB, WS_WO_T = 405 * MiB, WS_END = 413 * MiB;
constexpr size_t WS_KB = 4 * MiB, WS_VB = 20 * MiB, WS_QB = 36 * MiB, WS_SC = 60 * MiB;
constexpr size_t WS_PM = 184 * MiB;
constexpr size_t WS_YH = 52 * MiB, WS_YM = 68 * MiB;
constexpr size_t WS_MERGED = 104 * MiB, WS_MERGEDB = 168 * MiB;
constexpr size_t WS_R1 = 104 * MiB, WS_H1B = 168 * MiB;
constexpr size_t WS_WGU_T = 312 * MiB, WS_WD_T = 356 * MiB;
constexpr size_t WS_ACT = 216 * MiB;

constexpr int LDS_BYTES = 150 * 1024;

__device__ __forceinline__ float bf2f(bf16_t v) { return __uint_as_float((unsigned)v << 16); }
__device__ __forceinline__ unsigned f2bf(float f) { unsigned u = __float_as_uint(f); return (u + 0x7fffu + ((u >> 16) & 1u)) >> 16; }
__device__ __forceinline__ unsigned pk2(float lo, float hi) { return f2bf(lo) | (f2bf(hi) << 16); }
typedef __bf16 bf16x2_t __attribute__((ext_vector_type(2)));
typedef float f32x2_t __attribute__((ext_vector_type(2)));
__device__ __forceinline__ unsigned cvt_pk_bf16(float lo, float hi) { f32x2_t v = {lo, hi}; bf16x2_t b = __builtin_convertvector(v, bf16x2_t); return __builtin_bit_cast(unsigned, b); }
__device__ __forceinline__ u32x2 pk4(f32x4 v) { u32x2 w; w.x = cvt_pk_bf16(v[0], v[1]); w.y = cvt_pk_bf16(v[2], v[3]); return w; }
__device__ __forceinline__ f32x4 unpk4(u32x2 w) { f32x4 v; v[0] = __uint_as_float(w.x << 16); v[1] = __uint_as_float(w.x & 0xffff0000u); v[2] = __uint_as_float(w.y << 16); v[3] = __uint_as_float(w.y & 0xffff0000u); return v; }
__device__ __forceinline__ float wave_sum(float v) {
#pragma unroll
    for (int o = 1; o < 64; o <<= 1) v += __shfl_xor(v, o);
    return v;
}
__device__ __forceinline__ float wave_max(float v) {
#pragma unroll
    for (int o = 1; o < 64; o <<= 1) v = fmaxf(v, __shfl_xor(v, o));
    return v;
}
__device__ __forceinline__ float sigmoidf_(float v) { return __builtin_amdgcn_rcpf(1.f + __expf(-v)); }
#define LDS_WAIT() asm volatile("s_waitcnt lgkmcnt(0)" ::: "memory")

namespace pg8 {
constexpr int BM = 256, BK = 64, HALF = 128, HTB = HALF * BK * 2, STAGE_BYTES = 8 * HTB, NXCD = 8, WGM = 8;
__host__ __device__ __forceinline__ int lds_byte(int r, int c) { const int st = (r >> 4) * 2 + (c >> 5), rr = r & 15, cc = c & 31, ob = rr * 64 + cc * 2; return st * 1024 + (ob ^ (((ob >> 9) & 1) << 5)); }
__host__ __device__ __forceinline__ void stage_rc(int b, int& R, int& C) { const int st = b / 1024, sb = b % 1024, swz = sb ^ (((sb >> 9) & 1) << 5); R = (st >> 1) * 16 + swz / 64; C = (st & 1) * 32 + (swz % 64) / 2; }

struct Unit { int pm, pn, z; };
struct Sched {
    int nM, nN, nZ, nwg, G, c;
    const char* A0; const char* B;
    long a_pm, a_pn, a_z, b_pn, b_z;
    __device__ __forceinline__ void init(int M, int N, int nZ_, int G_, int c_) { nM = M / BM; nN = N / BM; nZ = nZ_; nwg = nM * nN; G = G_; c = c_; }
    __device__ __forceinline__ bool next(int i, Unit& u) const {
        const int z = i % nZ; const long L = (long)(i / nZ) * G + c; if (L >= nwg) return false;
        int wgid = (int)L; { const int q = nwg / NXCD, r = nwg % NXCD, xcd = wgid % NXCD, off = wgid / NXCD; wgid = (xcd < r ? xcd * (q + 1) : r * (q + 1) + (xcd - r) * q) + off; }
        const int nig = WGM * nN, gid = wgid / nig, fm = gid * WGM, gsz = (nM - fm) < WGM ? (nM - fm) : WGM;
        u.pm = fm + ((wgid % nig) % gsz); u.pn = (wgid % nig) / gsz; u.z = z; return true;
    }
    __device__ __forceinline__ const char* aptr(const Unit& u) const { return A0 + u.pm * a_pm + u.pn * a_pn + u.z * a_z; }
    __device__ __forceinline__ const char* bptr(const Unit& u) const { return B + u.pn * b_pn + u.z * b_z; }
};

template <class Epi, bool ALIGN_EPI>
__device__ __forceinline__ void gemm_phase(LAS unsigned char* lds, const int lda, const int ldb, const int K, const Sched& S, const Epi& E) {
    const int tid = threadIdx.x, wid = __builtin_amdgcn_readfirstlane(tid >> 6), lane = tid & 63, wr = wid >> 2, wc = wid & 3, fr = lane & 15, fq = lane >> 4;
    const int nt = K / BK;
    unsigned voffA[2], voffB[2];
#pragma unroll
    for (int i = 0; i < 2; ++i) { int R, C; stage_rc(tid * 16 + i * 8192, R, C); voffA[i] = (unsigned)(R * lda + C) * 2u; voffB[i] = (unsigned)(R * ldb + C) * 2u; }
    const size_t kstep = (size_t)(BK * 2);
    const size_t hstepA = (size_t)HALF * lda * 2, hstepB = (size_t)HALF * ldb * 2;
    const unsigned ldsw = (unsigned)wid * 1024u;
    const int aoff = lds_byte(wr * 64 + fr, fq * 8), boff = lds_byte(wc * 32 + fr, fq * 8);
#define PG8_SA(b, h) (((b) * 2 + (h)) * HTB)
#define PG8_SB(b, h) ((4 + (b) * 2 + (h)) * HTB)
#define PG8_STAGE(bufoff, gbase, voff) do { _Pragma("unroll") for (int _i = 0; _i < 2; ++_i) \
        __builtin_amdgcn_global_load_lds((const unsigned*)((const char*)(gbase) + (voff)[_i]), (LAS unsigned*)(lds + (bufoff) + ldsw + _i * 8192), 16, 0, 0); } while (0)
#define PG8_LDA(dst, b, h) do { _Pragma("unroll") for (int m = 0; m < 4; ++m) _Pragma("unroll") for (int k = 0; k < 2; ++k) dst[m][k] = *(const LAS bf16x8*)(lds + PG8_SA(b, h) + aoff + m * 2048 + k * 1024); } while (0)
#define PG8_LDB(dst, b, h) do { _Pragma("unroll") for (int n = 0; n < 2; ++n) _Pragma("unroll") for (int k = 0; k < 2; ++k) dst[n][k] = *(const LAS bf16x8*)(lds + PG8_SB(b, h) + boff + n * 2048 + k * 1024); } while (0)
#define PG8_MMA(ai, bj, At, Bt) do { __builtin_amdgcn_s_setprio(1); _Pragma("unroll") for (int m = 0; m < 4; ++m) _Pragma("unroll") for (int n = 0; n < 2; ++n) _Pragma("unroll") for (int k = 0; k < 2; ++k) \
        acc[ai][bj][m][n] = __builtin_amdgcn_mfma_f32_16x16x32_bf16(Bt[n][k], At[m][k], acc[ai][bj][m][n], 0, 0, 0); __builtin_amdgcn_s_setprio(0); } while (0)
#define PG8_WAIT_V(n) asm volatile("s_waitcnt vmcnt(" #n ")" ::: "memory")
#define PG8_WAIT_L(n) asm volatile("s_waitcnt lgkmcnt(" #n ")" ::: "memory")
#define PG8_BAR __builtin_amdgcn_s_barrier()
#define PG8_SCHED __builtin_amdgcn_sched_barrier(0)
    Unit cur, nxt; int ui = 0;
    if (!S.next(0, cur)) return;
    f32x4 acc[2][2][4][2];
#pragma unroll
    for (int a = 0; a < 2; ++a)
#pragma unroll
        for (int b = 0; b < 2; ++b)
#pragma unroll
            for (int m = 0; m < 4; ++m)
#pragma unroll
                for (int n = 0; n < 2; ++n) acc[a][b][m][n] = (f32x4){0.f, 0.f, 0.f, 0.f};
    bf16x8 At[4][2], B0[2][2], B1[2][2];
    const char* cA = S.aptr(cur); const char* cB = S.bptr(cur);
    PG8_STAGE(PG8_SB(0, 0), cB, voffB); PG8_STAGE(PG8_SB(0, 1), cB + hstepB, voffB); PG8_STAGE(PG8_SA(0, 0), cA, voffA); PG8_STAGE(PG8_SA(0, 1), cA + hstepA, voffA);
    if (wr == 1) PG8_BAR;
    PG8_WAIT_V(2); PG8_BAR;
    PG8_STAGE(PG8_SB(1, 0), cB + kstep, voffB); PG8_STAGE(PG8_SA(1, 0), cA + kstep, voffA); PG8_STAGE(PG8_SB(1, 1), cB + hstepB + kstep, voffB);
    PG8_WAIT_V(6); PG8_BAR;
    for (;;) {
        const bool has_next = S.next(ui + 1, nxt);
        const char* nA = has_next ? S.aptr(nxt) : cA; const char* nB = has_next ? S.bptr(nxt) : cB;
        for (int t = 0; t < nt; t += 2) {
            const bool last = (t == nt - 2);
            const char* a1 = cA + (size_t)(t + 1) * kstep;
            const char* a2 = last ? nA : cA + (size_t)(t + 2) * kstep; const char* b2 = last ? nB : cB + (size_t)(t + 2) * kstep;
            const char* a3 = a2 + kstep; const char* b3 = b2 + kstep;
            PG8_LDB(B0, 0, 0); PG8_LDB(B1, 0, 1); PG8_SCHED; PG8_LDA(At, 0, 0); PG8_STAGE(PG8_SA(1, 1), a1 + hstepA, voffA);
            PG8_WAIT_V(8); PG8_WAIT_L(0); PG8_BAR; PG8_MMA(0, 0, At, B0); PG8_MMA(0, 1, At, B1); PG8_BAR; PG8_SCHED;
            PG8_LDA(At, 0, 1); PG8_STAGE(PG8_SB(0, 0), b2, voffB); PG8_STAGE(PG8_SB(0, 1), b2 + hstepB, voffB); PG8_STAGE(PG8_SA(0, 0), a2, voffA);
            PG8_WAIT_V(8); PG8_WAIT_L(0); PG8_BAR; PG8_MMA(1, 0, At, B0); PG8_MMA(1, 1, At, B1); PG8_BAR; PG8_SCHED;
            PG8_LDB(B0, 1, 0); PG8_LDB(B1, 1, 1); PG8_SCHED; PG8_LDA(At, 1, 0); PG8_STAGE(PG8_SA(0, 1), a2 + hstepA, voffA);
            PG8_WAIT_V(8); PG8_WAIT_L(0); PG8_BAR; PG8_MMA(0, 0, At, B0); PG8_MMA(0, 1, At, B1); PG8_BAR; PG8_SCHED;
            PG8_LDA(At, 1, 1); PG8_STAGE(PG8_SB(1, 0), b3, voffB); PG8_STAGE(PG8_SB(1, 1), b3 + hstepB, voffB); PG8_STAGE(PG8_SA(1, 0), a3, voffA);
            PG8_WAIT_V(8); PG8_WAIT_L(0); PG8_BAR; PG8_MMA(1, 0, At, B0); PG8_MMA(1, 1, At, B1); PG8_BAR; PG8_SCHED;
        }
        if constexpr (ALIGN_EPI) { if (wr == 0) PG8_BAR; }
        E(acc, cur, wr, wc, fr, fq);
        if (!has_next) break;
#pragma unroll
        for (int a = 0; a < 2; ++a)
#pragma unroll
            for (int b = 0; b < 2; ++b)
#pragma unroll
                for (int m = 0; m < 4; ++m)
#pragma unroll
                    for (int n = 0; n < 2; ++n) acc[a][b][m][n] = (f32x4){0.f, 0.f, 0.f, 0.f};
        cur = nxt; cA = nA; cB = nB; ++ui;
        if constexpr (ALIGN_EPI) { if (wr == 1) PG8_BAR; }
    }
    PG8_WAIT_V(0);
    if constexpr (!ALIGN_EPI) { if (wr == 0) PG8_BAR; }
    PG8_BAR;
#undef PG8_SA
#undef PG8_SB
#undef PG8_STAGE
#undef PG8_LDA
#undef PG8_LDB
#undef PG8_MMA
#undef PG8_WAIT_V
#undef PG8_WAIT_L
#undef PG8_BAR
#undef PG8_SCHED
}

#define EPI_ARGS const f32x4 (&acc)[2][2][4][2], const Unit& u, int wr, int wc, int fr, int fq
#define EPI_ROWS for (int ai = 0; ai < 2; ++ai) for (int m = 0; m < 4; ++m)
#define EPI_COLS for (int bj = 0; bj < 2; ++bj) for (int n = 0; n < 2; ++n)

struct EpiStore {
    bf16_t* O; int ldc; float scale;
    __device__ __forceinline__ void operator()(EPI_ARGS) const {
        const int row0 = u.pm * BM + wr * 64 + fr, col0 = u.pn * BM + wc * 32 + 4 * fq;
#pragma unroll
        EPI_ROWS { bf16_t* rp = O + (size_t)(row0 + ai * HALF + m * 16) * ldc + col0;
#pragma unroll
            EPI_COLS { *(u32x2*)(rp + bj * HALF + n * 16) = pk4(acc[ai][bj][m][n] * scale); } }
    }
};

struct EpiP1 {
    bf16_t *QH, *VH, *GF, *GH, *CQ, *CKV, *QM, *GS, *KR; float* SSQ; const float *LB, *COS, *SIN;
    __device__ __forceinline__ void operator()(EPI_ARGS) const {
        const int pn = u.pn; const int row0 = u.pm * BM + wr * 64 + fr; const int ct = wc * 32 + 4 * fq;
        if (pn == 52) {
            if (wc < 2) {
                const int i0 = 16 * wc + 4 * fq;
#pragma unroll
                EPI_ROWS { const int row = row0 + ai * HALF + m * 16;
                    const f32x4 cs = *(const f32x4*)(COS + (size_t)row * 32 + i0), sn = *(const f32x4*)(SIN + (size_t)row * 32 + i0);
                    const f32x4 x1 = acc[ai][0][m][0], x2 = acc[ai][0][m][1];
                    const f32x4 o1 = x1 * cs - x2 * sn, o2 = x2 * cs + x1 * sn;
                    bf16_t* rp = KR + (size_t)row * 64 + 32 * wc + 4 * fq;
                    *(u32x2*)(rp) = pk4(o1); *(u32x2*)(rp + 16) = pk4(o2); }
            }
            return;
        }
        int op, ld, c0, ssq = -1; bf16_t* dst; const float* lbp = nullptr;
        if (pn < 4) { op = 1; dst = QH; ld = 1024; c0 = 256 * pn; }
        else if (pn < 8) { op = 0; dst = VH; ld = 1024; c0 = 256 * (pn - 4); }
        else if (pn < 16) { const int z = (pn >= 12) ? 1 : 0; op = 3; dst = GF + (size_t)z * S * 1024; ld = 1024; c0 = 256 * ((pn - 8) & 3); lbp = LB + z * 1024 + c0 + ct; }
        else if (pn < 20) { op = 2; dst = GH; ld = 1024; c0 = 256 * (pn - 16); }
        else if (pn < 22) { op = 0; dst = CQ; ld = 512; c0 = 256 * (pn - 20); ssq = 0; }
        else if (pn < 24) { op = 0; dst = CKV; ld = 512; c0 = 256 * (pn - 22); ssq = 1; }
        else if (pn < 28) { op = 0; dst = QM; ld = 1024; c0 = 256 * (pn - 24); }
        else { op = 2; dst = GS; ld = 6144; c0 = 256 * (pn - 28); }
        f32x4 lbv[2][2];
#pragma unroll
        EPI_COLS lbv[bj][n] = (op == 3) ? *(const f32x4*)(lbp + bj * HALF + n * 16) : (f32x4){0.f, 0.f, 0.f, 0.f};
#pragma unroll
        EPI_ROWS { const int row = row0 + ai * HALF + m * 16; bf16_t* rp = dst + (size_t)row * ld + c0 + ct; float ss = 0.f;
#pragma unroll
            EPI_COLS { f32x4 v = acc[ai][bj][m][n];
                if (op != 0) {
#pragma unroll
                    for (int e = 0; e < 4; ++e) { const float x = v[e]; const float sg = sigmoidf_(x);
                        float r = sg; if (op == 1) r = x * sg; else if (op == 3) { const float lb = lbv[bj][n][e]; r = __logf(lb + (1.f - lb) * sg); }
                        v[e] = r; }
                }
                ss += (v[0] * v[0] + v[1] * v[1]) + (v[2] * v[2] + v[3] * v[3]);
                *(u32x2*)(rp + bj * HALF + n * 16) = pk4(v); }
            if (ssq >= 0) { ss += __shfl_xor(ss, 16); ss += __shfl_xor(ss, 32); if (fq == 0) SSQ[((size_t)ssq * S + row) * 8 + (pn & 1) * 4 + wc] = ss; }
        }
    }
};

struct EpiQ {
    bf16_t* QB; const float *SSQ, *COS, *SIN;
    __device__ __forceinline__ void operator()(EPI_ARGS) const {
        const int row0 = u.pm * BM + wr * 64 + fr;
#pragma unroll
        EPI_ROWS { const int row = row0 + ai * HALF + m * 16; const f32x4 sa = *(const f32x4*)(SSQ + (size_t)row * 8), sb2 = *(const f32x4*)(SSQ + (size_t)row * 8 + 4); const float rstd = rsqrtf((((sa[0] + sa[1]) + (sa[2] + sa[3])) + ((sb2[0] + sb2[1]) + (sb2[2] + sb2[3]))) * (1.f / 512.f) + RMS_EPS);
#pragma unroll
            for (int bj = 0; bj < 2; ++bj) { const int gg = 8 * u.pn + 4 * bj + wc, part = gg % 6;
                f32x4 x1 = acc[ai][bj][m][0] * rstd, x2 = acc[ai][bj][m][1] * rstd;
                if (part >= 4) { const int i0 = (part - 4) * 16 + 4 * fq;
                    const f32x4 cs = *(const f32x4*)(COS + (size_t)row * 32 + i0), sn = *(const f32x4*)(SIN + (size_t)row * 32 + i0);
                    const f32x4 o1 = x1 * cs - x2 * sn, o2 = x2 * cs + x1 * sn; x1 = o1; x2 = o2; }
                bf16_t* rp = QB + (size_t)row * 1536 + 32 * gg + 4 * fq;
                *(u32x2*)(rp) = pk4(x1); *(u32x2*)(rp + 16) = pk4(x2); } }
    }
};
struct EpiKV {
    bf16_t *KB, *VB; const float* SSQ;
    __device__ __forceinline__ void operator()(EPI_ARGS) const {
        const int row0 = u.pm * BM + wr * 64 + fr; const int c = u.pn * 128 + wc * 32 + 4 * fq;
#pragma unroll
        EPI_ROWS { const int row = row0 + ai * HALF + m * 16; const f32x4 sa = *(const f32x4*)(SSQ + (size_t)row * 8), sb2 = *(const f32x4*)(SSQ + (size_t)row * 8 + 4); const float rstd = rsqrtf((((sa[0] + sa[1]) + (sa[2] + sa[3])) + ((sb2[0] + sb2[1]) + (sb2[2] + sb2[3]))) * (1.f / 512.f) + RMS_EPS);
#pragma unroll
            for (int n = 0; n < 2; ++n) { *(u32x2*)(KB + (size_t)row * 1024 + c + 16 * n) = pk4(acc[ai][0][m][n] * rstd); *(u32x2*)(VB + (size_t)row * 1024 + c + 16 * n) = pk4(acc[ai][1][m][n] * rstd); } }
    }
};
struct EpiMerge {
    const bf16_t* GS; float* MG; bf16_t* MGB;
    __device__ __forceinline__ void operator()(EPI_ARGS) const {
        const int row0 = u.pm * BM + wr * 64 + fr, col0 = u.pn * BM + wc * 32 + 4 * fq; const int z = u.z, gz = (3 - z) % 3;
#pragma unroll
        EPI_ROWS { const size_t row = (size_t)(row0 + ai * HALF + m * 16);
#pragma unroll
            EPI_COLS { const int col = col0 + bj * HALF + n * 16;
                const f32x4 g = unpk4(*(const u32x2*)(GS + row * 6144 + gz * 2048 + col));
                f32x4 v = g * acc[ai][bj][m][n];
                if (z > 0) v += *(const f32x4*)(MG + row * DM + col);
                if (z < 2) *(f32x4*)(MG + row * DM + col) = v; else *(u32x2*)(MGB + row * DM + col) = pk4(v); } }
    }
};
struct EpiWo {
    const float *X, *STATS, *G, *Bv; float* R1;
    __device__ __forceinline__ void operator()(EPI_ARGS) const {
        const int row0 = u.pm * BM + wr * 64 + fr, col0 = u.pn * BM + wc * 32 + 4 * fq;
        f32x4 gv[2][2], bv[2][2];
#pragma unroll
        EPI_COLS { gv[bj][n] = *(const f32x4*)(G + col0 + bj * HALF + n * 16); bv[bj][n] = *(const f32x4*)(Bv + col0 + bj * HALF + n * 16); }
#pragma unroll
        EPI_ROWS { const size_t row = (size_t)(row0 + ai * HALF + m * 16); const float mean = STATS[2 * row], rstd = STATS[2 * row + 1];
#pragma unroll
            EPI_COLS { const int col = col0 + bj * HALF + n * 16; const f32x4 x = *(const f32x4*)(X + row * DM + col);
                const f32x4 h = (x - mean) * rstd * gv[bj][n] + bv[bj][n];
                *(f32x4*)(R1 + row * DM + col) = h * ALPHA + acc[ai][bj][m][n]; } }
    }
};
struct EpiGU {
    bf16_t* ACT;
    __device__ __forceinline__ void operator()(EPI_ARGS) const {
        const int row0 = u.pm * BM + wr * 64 + fr;
#pragma unroll
        EPI_ROWS { const size_t row = (size_t)(row0 + ai * HALF + m * 16);
#pragma unroll
            for (int bj = 0; bj < 2; ++bj) { const int grp = 8 * u.pn + 4 * bj + wc; const f32x4 g = acc[ai][bj][m][0], up = acc[ai][bj][m][1]; f32x4 o;
#pragma unroll
                for (int e = 0; e < 4; ++e) o[e] = g[e] * sigmoidf_(g[e]) * up[e];
                *(u32x2*)(ACT + row * LDACT + 16 * grp + 4 * fq) = pk4(o); } }
    }
};
struct EpiDown {
    const float* H1; float* OUT;
    __device__ __forceinline__ void operator()(EPI_ARGS) const {
        const int row0 = u.pm * BM + wr * 64 + fr, col0 = u.pn * BM + wc * 32 + 4 * fq;
#pragma unroll
        EPI_ROWS { const size_t row = (size_t)(row0 + ai * HALF + m * 16);
#pragma unroll
            EPI_COLS { const int col = col0 + bj * HALF + n * 16; *(f32x4*)(OUT + row * DM + col) = *(const f32x4*)(H1 + row * DM + col) * ALPHA + acc[ai][bj][m][n]; } }
    }
};
}

namespace mla {
constexpr int NW = 8, QBLK = 32, KVBLK = 64;
constexpr float SCALE = 0.07216878364870322f;
constexpr float THR = 8.f;
constexpr int LDQ = 1536, LDKN = 1024, LDKR = 64, LDV = 1024, LDO = 1024;
constexpr int SHM_V = 64 * 128 * 2, SHM_K = 64 * 192 * 2;
#define KSWZ(row, colB) ((row) * 384 + ((colB) ^ (((row) & 7) << 4)))
#define SBAR() __builtin_amdgcn_sched_barrier(0)
__device__ __forceinline__ int crow(int r, int hi) { return (r & 3) + 8 * (r >> 2) + 4 * hi; }
__device__ __forceinline__ unsigned cvtpk(float lo, float hi) { unsigned r; asm volatile("v_cvt_pk_bf16_f32 %0, %1, %2" : "=v"(r) : "v"(lo), "v"(hi)); return r; }

__device__ __forceinline__ void partialSM(f32x16& p0, f32x16& p1, float& m_reg, float& mn, float& alpha) {
    constexpr float C = SCALE * 1.4426950408889634f;
    float pmax = p0[0];
#pragma unroll
    for (int r = 1; r < 16; ++r) pmax = fmaxf(pmax, p0[r]);
#pragma unroll
    for (int r = 0; r < 16; ++r) pmax = fmaxf(pmax, p1[r]);
    { auto rr = __builtin_amdgcn_permlane32_swap(__float_as_uint(pmax), __float_as_uint(pmax), false, false);
      pmax = fmaxf(__uint_as_float(rr[0]), __uint_as_float(rr[1])); }
    if (__builtin_expect(__all(pmax - m_reg <= THR / SCALE), 1)) { mn = m_reg; alpha = 1.f; }
    else { mn = fmaxf(m_reg, pmax); alpha = __builtin_amdgcn_exp2f((m_reg - mn) * C); m_reg = mn; }
    float mnC = -mn * C;
#pragma unroll
    for (int r = 0; r < 16; ++r) p0[r] = fmaf(p0[r], C, mnC);
#pragma unroll
    for (int r = 0; r < 16; ++r) p1[r] = fmaf(p1[r], C, mnC);
#pragma unroll
    for (int r = 0; r < 16; ++r) p0[r] = __builtin_amdgcn_exp2f(p0[r]);
}
__device__ __forceinline__ void finishSM(f32x16& p0, f32x16& p1, float alpha, float& l_reg, bf16x8& pa0, bf16x8& pa1, bf16x8& pa2, bf16x8& pa3) {
#pragma unroll
    for (int r = 0; r < 16; ++r) p1[r] = __builtin_amdgcn_exp2f(p1[r]);
    float ps = 0;
#pragma unroll
    for (int r = 0; r < 16; ++r) ps += p0[r];
#pragma unroll
    for (int r = 0; r < 16; ++r) ps += p1[r];
    { auto rr = __builtin_amdgcn_permlane32_swap(__float_as_uint(ps), __float_as_uint(ps), false, false);
      ps = __uint_as_float(rr[0]) + __uint_as_float(rr[1]); }
    l_reg = l_reg * alpha + ps;
#define PK4(P, BASE, OUT) do { unsigned a0 = cvtpk(P[BASE + 0], P[BASE + 1]), a1 = cvtpk(P[BASE + 2], P[BASE + 3]);   \
    unsigned b0 = cvtpk(P[BASE + 4], P[BASE + 5]), b1 = cvtpk(P[BASE + 6], P[BASE + 7]);                              \
    auto r0 = __builtin_amdgcn_permlane32_swap(a0, b0, false, false); auto r1 = __builtin_amdgcn_permlane32_swap(a1, b1, false, false); \
    u32x4 w = {r0[0], r1[0], r0[1], r1[1]}; OUT = *reinterpret_cast<bf16x8*>(&w); } while (0)
    PK4(p0, 0, pa0); PK4(p0, 8, pa1); PK4(p1, 0, pa2); PK4(p1, 8, pa3);
#undef PK4
}
__device__ __forceinline__ void qkt(f32x16& p0, f32x16& p1, const char* Ks, const bf16x8* qr, int r32, int hi) {
    p0 = f32x16{}; p1 = f32x16{};
#pragma unroll
    for (int d0 = 0; d0 < 12; ++d0) { int cb = (d0 * 16 + hi * 8) * 2;
        bf16x8 b0 = *reinterpret_cast<const bf16x8*>(Ks + KSWZ(r32, cb));
        bf16x8 b1 = *reinterpret_cast<const bf16x8*>(Ks + KSWZ(32 + r32, cb));
        p0 = __builtin_amdgcn_mfma_f32_32x32x16_bf16(b0, qr[d0], p0, 0, 0, 0);
        p1 = __builtin_amdgcn_mfma_f32_32x32x16_bf16(b1, qr[d0], p1, 0, 0, 0); }
}
__device__ __forceinline__ int v_st(int k, int c) { const int kk = (k & ~0xC) | ((k & 4) << 1) | ((k & 8) >> 1); return ((kk >> 3) * 4 + (c >> 5)) * 512 + ((kk & 7) * 32 + (c & 31)) * 2; }
__device__ __forceinline__ int v_rd_base(int lane) { return ((lane & 3) << 3) | (((lane >> 2) & 3) << 6) | (((lane >> 4) & 1) << 5) | (((lane >> 5) & 1) << 8); }
constexpr int v_rd_off(int d0, int ks, int half) { return d0 * 512 + ks * 4096 + half * 2048; }
template <int OFF> __device__ __forceinline__ s16x4 tr_read(int vb) {
    s16x4 r; asm volatile("ds_read_b64_tr_b16 %0, %1 offset:%2" : "=&v"(r) : "v"(vb), "i"(OFF) : "memory"); return r;
}
template <int D0> __device__ __forceinline__ void pv_one(f32x16& od, int vb, bf16x8 pa0, bf16x8 pa1, bf16x8 pa2, bf16x8 pa3) {
    const s16x4 l0 = tr_read<v_rd_off(D0, 0, 0)>(vb), h0 = tr_read<v_rd_off(D0, 0, 1)>(vb), l1 = tr_read<v_rd_off(D0, 1, 0)>(vb), h1 = tr_read<v_rd_off(D0, 1, 1)>(vb);
    const s16x4 l2 = tr_read<v_rd_off(D0, 2, 0)>(vb), h2 = tr_read<v_rd_off(D0, 2, 1)>(vb), l3 = tr_read<v_rd_off(D0, 3, 0)>(vb), h3 = tr_read<v_rd_off(D0, 3, 1)>(vb);
    asm volatile("s_waitcnt lgkmcnt(0)" ::: "memory"); SBAR();
#define PK(L, H) (bf16x8){L[0], L[1], L[2], L[3], H[0], H[1], H[2], H[3]}
    od = __builtin_amdgcn_mfma_f32_32x32x16_bf16(pa0, PK(l0, h0), od, 0, 0, 0);
    od = __builtin_amdgcn_mfma_f32_32x32x16_bf16(pa1, PK(l1, h1), od, 0, 0, 0);
    od = __builtin_amdgcn_mfma_f32_32x32x16_bf16(pa2, PK(l2, h2), od, 0, 0, 0);
    od = __builtin_amdgcn_mfma_f32_32x32x16_bf16(pa3, PK(l3, h3), od, 0, 0, 0);
#undef PK
}
__device__ __forceinline__ void pv_d0(f32x16* o, int vb, bf16x8 pa0, bf16x8 pa1, bf16x8 pa2, bf16x8 pa3) {
    pv_one<0>(o[0], vb, pa0, pa1, pa2, pa3); pv_one<1>(o[1], vb, pa0, pa1, pa2, pa3); pv_one<2>(o[2], vb, pa0, pa1, pa2, pa3); pv_one<3>(o[3], vb, pa0, pa1, pa2, pa3);
}

__device__ __forceinline__ void attn_unit(const bf16_t* __restrict__ Qb, const bf16_t* __restrict__ Kn, const bf16_t* __restrict__ Kr, const bf16_t* __restrict__ Vh,
                                          bf16_t* __restrict__ Ob, int seq, char* lds) {
    const int tid = threadIdx.x, wid = tid >> 6, lane = tid & 63, r32 = lane & 31, hi = lane >> 5;
    char* V_lds = lds; char* K_lds = lds + 2 * SHM_V;
    float* ws = (float*)(lds + 2 * SHM_V + 2 * SHM_K) + wid * 64; float* li_l = ws; float* al_l = ws + 32;
    float m_reg = -1e30f, l_reg = 0; f32x16 o[4] = {}; bf16x8 qr[12];
    const bf16_t* Qw = Qb + (long)(wid * QBLK + r32) * LDQ + hi * 8;
#pragma unroll
    for (int d0 = 0; d0 < 12; ++d0) qr[d0] = *reinterpret_cast<const bf16x8*>(Qw + d0 * 16);
    const int sr = tid >> 4, sc = (tid & 15) * 8, vst0 = v_st(sr, sc), vst1 = v_st(32 + sr, sc);
    const int vb0 = (int)(uintptr_t)V_lds + v_rd_base(lane);
    const bf16_t* kp[3]; int kstr[3], kst[3];
#pragma unroll
    for (int i = 0; i < 3; ++i) { const int q = tid + 512 * i, row = q / 24, cc = q % 24;
        kp[i] = (cc < 16) ? (Kn + (long)row * LDKN + cc * 8) : (Kr + (long)row * LDKR + (cc - 16) * 8); kstr[i] = (cc < 16) ? LDKN : LDKR; kst[i] = KSWZ(row, cc * 16); }
    bf16x8 vs0, vs1, ks0, ks1, ks2;
#define SLOAD(k0) do { vs0 = *reinterpret_cast<const bf16x8*>(&Vh[(long)((k0) + sr) * LDV + sc]); vs1 = *reinterpret_cast<const bf16x8*>(&Vh[(long)((k0) + 32 + sr) * LDV + sc]); \
    ks0 = *reinterpret_cast<const bf16x8*>(kp[0] + (long)(k0) * kstr[0]); ks1 = *reinterpret_cast<const bf16x8*>(kp[1] + (long)(k0) * kstr[1]); ks2 = *reinterpret_cast<const bf16x8*>(kp[2] + (long)(k0) * kstr[2]); } while (0)
#define SWRITE(b) do { *(bf16x8*)(V_lds + (b) * SHM_V + vst0) = vs0; *(bf16x8*)(V_lds + (b) * SHM_V + vst1) = vs1; \
    *(bf16x8*)(K_lds + (b) * SHM_K + kst[0]) = ks0; *(bf16x8*)(K_lds + (b) * SHM_K + kst[1]) = ks1; *(bf16x8*)(K_lds + (b) * SHM_K + kst[2]) = ks2; } while (0)
#define SWAIT() asm volatile("s_waitcnt vmcnt(0)" ::: "memory")
#define RESC(a) do { if (__any((a) < 1.f)) { if (hi == 0) al_l[r32] = (a); asm volatile("s_waitcnt lgkmcnt(0)" ::: "memory"); \
    _Pragma("unroll") for (int d = 0; d < 4; ++d) _Pragma("unroll") for (int r = 0; r < 16; ++r) o[d][r] *= al_l[crow(r, hi)]; } } while (0)
    f32x16 pA0, pA1; float mnA, alA; bf16x8 pa0, pa1, pa2, pa3; const int NT = seq / KVBLK;
    SLOAD(0); SWAIT(); SWRITE(0); __syncthreads();
#pragma unroll 1
    for (int j = 0; j < NT; ++j) {
        const int buf = j & 1;
        if (j + 1 < NT) SLOAD((j + 1) * KVBLK);
        SBAR(); qkt(pA0, pA1, K_lds + buf * SHM_K, qr, r32, hi);
        partialSM(pA0, pA1, m_reg, mnA, alA);
        RESC(alA);
        finishSM(pA0, pA1, alA, l_reg, pa0, pa1, pa2, pa3); SBAR();
        pv_d0(o, vb0 + buf * (int)SHM_V, pa0, pa1, pa2, pa3);
        if (j + 1 < NT) { SWAIT(); SWRITE(buf ^ 1); }
        __syncthreads();
    }
    if (hi == 0) li_l[r32] = l_reg; asm volatile("s_waitcnt lgkmcnt(0)" ::: "memory");
    float rli[16];
#pragma unroll
    for (int r = 0; r < 16; ++r) rli[r] = __builtin_amdgcn_rcpf(li_l[crow(r, hi)]);
    bf16_t* Ow = Ob + (long)(wid * QBLK) * LDO;
#pragma unroll
    for (int r = 0; r < 16; ++r) { int orow = crow(r, hi);
#pragma unroll
        for (int d0 = 0; d0 < 4; ++d0) Ow[(long)orow * LDO + d0 * 32 + r32] = (bf16_t)f2bf(o[d0][r] * rli[r]); }
    __syncthreads();
#undef SLOAD
#undef SWRITE
#undef SWAIT
#undef RESC
}
#undef SBAR
}

struct Args { const float* in[22]; float* out; unsigned char* ws; int ph_lo, ph_hi; };

__device__ __forceinline__ const float* tr_src(int mode, const float* Wa, const float* Wb, int nd, int run) {
    if (mode == 0) return Wa + nd + 16 * run;
    if (mode == 1) { if (nd < 6144) return Wa + nd + 16 * run; if (nd < 13312) return Wa + nd + 64 + 16 * run; if (nd < 13376) return Wa + 6144 + 16 * ((nd - 13312) >> 5) + 32 * run; return nullptr; }
    if (mode == 2) { const int grp = nd >> 5, part = grp % 6, h = grp / 6; if (part < 4) return Wa + nd + 16 * run; return Wa + 192 * h + 128 + 16 * (part - 4) + 32 * run; }
    return (run ? Wb : Wa) + 16 * (nd >> 5);
}
__device__ __forceinline__ void tr_item2(int mode, const float* Wa, const float* Wb, int ldw, int k0, int n0, bf16_t* WT, int ldt, const float* ksc, float* scr, int lane) {
    const int j = lane & 15, kq = lane >> 4;
    const float* src = tr_src(mode, Wa, Wb, n0 + 32 * (j >> 3), (j >> 2) & 1);
    f32x4 v[16];
#pragma unroll
    for (int i = 0; i < 16; ++i) { const int kk = kq + 4 * i; v[i] = src ? *(const f32x4*)(src + (size_t)(k0 + kk) * ldw + 4 * (j & 3)) : (f32x4){0.f, 0.f, 0.f, 0.f}; }
#pragma unroll
    for (int i = 0; i < 16; ++i) { const int kk = kq + 4 * i; f32x4 w = v[i]; if (ksc) w = w * ksc[k0 + kk]; float* d = scr + kk * 65 + 4 * j; d[0] = w[0]; d[1] = w[1]; d[2] = w[2]; d[3] = w[3]; }
    LDS_WAIT();
    const int c = lane & 7;
#pragma unroll
    for (int t = 0; t < 8; ++t) { const int n = (lane >> 3) + 8 * t; const float* sp = scr + (8 * c) * 65 + n;
        u32x4 o; o.x = pk2(sp[0 * 65], sp[1 * 65]); o.y = pk2(sp[2 * 65], sp[3 * 65]); o.z = pk2(sp[4 * 65], sp[5 * 65]); o.w = pk2(sp[6 * 65], sp[7 * 65]);
        *(u32x4*)(WT + (size_t)(n0 + n) * ldt + k0 + 8 * c) = o; }
    LDS_WAIT();
}
__device__ __forceinline__ void tr_mat(int mode, const float* Wa, const float* Wb, int K, int ldw, int N, bf16_t* WT, int ldt, const float* ksc, float* scr, int lane, int gw, int NGW) {
    const int nkb = K / 64, nit = nkb * (N / 64);
    for (int it = gw; it < nit; it += NGW) { const int nb = it / nkb, kb = it % nkb; tr_item2(mode, Wa, Wb, ldw, 64 * kb, 64 * nb, WT, ldt, ksc, scr, lane); }
}
__device__ __forceinline__ void ln_row(const float* xrow, const float* g, const float* b, float* of, bf16_t* ob, float* stats, int lane) {
    const f32x4* xr = (const f32x4*)xrow + lane;
    f32x4 v[8]; float s = 0.f;
#pragma unroll
    for (int j = 0; j < 8; ++j) { v[j] = xr[64 * j]; s += (v[j][0] + v[j][1]) + (v[j][2] + v[j][3]); }
    const float mean = wave_sum(s) * (1.f / DM); float s2 = 0.f;
#pragma unroll
    for (int j = 0; j < 8; ++j) { v[j] = v[j] - mean; s2 += (v[j][0] * v[j][0] + v[j][1] * v[j][1]) + (v[j][2] * v[j][2] + v[j][3] * v[j][3]); }
    const float rstd = rsqrtf(wave_sum(s2) * (1.f / DM) + LN_EPS);
    if (stats && lane == 0) { stats[0] = mean; stats[1] = rstd; }
#pragma unroll
    for (int j = 0; j < 8; ++j) { const f32x4 gv = ((const f32x4*)g)[64 * j + lane], bv = ((const f32x4*)b)[64 * j + lane]; const f32x4 y = v[j] * rstd * gv + bv;
        if (of) ((f32x4*)of)[64 * j + lane] = y;
        if (ob) ((u32x2*)ob)[64 * j + lane] = pk4(y); }
}

__global__ void __launch_bounds__(512) mega(Args a) {
    extern __shared__ __attribute__((aligned(16))) unsigned char lds[];
    cg::grid_group grid = cg::this_grid();
    const int tid = threadIdx.x, lane = tid & 63, wave = __builtin_amdgcn_readfirstlane(tid >> 6);
    const int G = gridDim.x, bid = blockIdx.x;
    const int gw = bid * 8 + wave, NGW = G * 8;
    unsigned char* ws = a.ws;
    LAS unsigned char* ldsl = (LAS unsigned char*)lds;
    const float* x = a.in[0]; const float* memp = a.in[1]; const int* positions = (const int*)a.in[2];
    const float *ln_emb_g = a.in[3], *ln_emb_b = a.in[4], *lb_logits = a.in[5], *w_in = a.in[6], *hg_norm_g = a.in[7], *g_cq = a.in[8], *g_ckv = a.in[9];
    const float *w_uq = a.in[10], *w_ukv = a.in[11], *w_kvm = a.in[12], *w_branch = a.in[13], *w_o = a.in[14], *ln1_g = a.in[15], *ln1_b = a.in[16];
    const float *w_gate = a.in[17], *w_up = a.in[18], *w_down = a.in[19], *ln2_g = a.in[20], *ln2_b = a.in[21];
    float* out = a.out;
#define WSP(T, off) ((T*)(ws + (off)))
    float* SSQ = WSP(float, WS_SSQ); float* STATS = WSP(float, WS_STATS); float* LB = WSP(float, WS_LB);
    float* COS = WSP(float, WS_COS); float* SIN = WSP(float, WS_SIN); float* DVEC = WSP(float, WS_DVEC);
    bf16_t *WIN_T = WSP(bf16_t, WS_WIN_T), *H0B = WSP(bf16_t, WS_H0B), *WUQ_T = WSP(bf16_t, WS_WUQ_T), *WUKV_T = WSP(bf16_t, WS_WUKV_T), *WKV_T = WSP(bf16_t, WS_WKV_T), *MEMB = WSP(bf16_t, WS_MEMB);
    bf16_t *KVM = WSP(bf16_t, WS_KVM), *VMT = WSP(bf16_t, WS_VMT), *KR = WSP(bf16_t, WS_KR);
    bf16_t *QH = WSP(bf16_t, WS_QH), *VH = WSP(bf16_t, WS_VH), *GF = WSP(bf16_t, WS_GF), *GH = WSP(bf16_t, WS_GH), *CQ = WSP(bf16_t, WS_CQ), *CKV = WSP(bf16_t, WS_CKV), *QM = WSP(bf16_t, WS_QM), *GS = WSP(bf16_t, WS_GS);
    bf16_t *HS = WSP(bf16_t, WS_HS), *YA = WSP(bf16_t, WS_YA), *WBR_T = WSP(bf16_t, WS_WBR_T), *WO_T = WSP(bf16_t, WS_WO_T);
    bf16_t *KB = WSP(bf16_t, WS_KB), *VB = WSP(bf16_t, WS_VB), *QB = WSP(bf16_t, WS_QB), *SC = WSP(bf16_t, WS_SC), *PM = WSP(bf16_t, WS_PM), *YH = WSP(bf16_t, WS_YH), *YM = WSP(bf16_t, WS_YM);
    float* MERGED = WSP(float, WS_MERGED); bf16_t* MERGEDB = WSP(bf16_t, WS_MERGEDB); float* R1 = WSP(float, WS_R1); bf16_t* H1B = WSP(bf16_t, WS_H1B);
    bf16_t *WGU_T = WSP(bf16_t, WS_WGU_T), *WD_T = WSP(bf16_t, WS_WD_T), *ACT = WSP(bf16_t, WS_ACT);

#ifndef PHMASK
#define PHMASK 0x7ff
#endif
#define IN(k) (((PHMASK >> (k)) & 1) && a.ph_lo <= (k) && (k) < a.ph_hi)
#define SEAM(k) do { if (IN(k) && IN((k) + 1)) { asm volatile("s_waitcnt vmcnt(0)" ::: "memory"); __threadfence(); grid.sync(); __builtin_amdgcn_fence(__ATOMIC_ACQUIRE, "agent"); asm volatile("s_waitcnt vmcnt(0)" ::: "memory"); } } while (0)

    if (IN(0)) {
        float* scr = (float*)lds + wave * (64 * 65);
        tr_mat(1, w_in, w_in, DM, 13376, NINP, WIN_T, DM, nullptr, scr, lane, gw, NGW);
        tr_mat(2, w_uq, w_uq, 512, 1536, 1536, WUQ_T, 512, g_cq, scr, lane, gw, NGW);
        tr_mat(0, w_ukv, w_ukv, 512, 2048, 2048, WUKV_T, 512, g_ckv, scr, lane, gw, NGW);
        tr_mat(0, w_kvm, w_kvm, 2048, 2048, 2048, WKV_T, DM, nullptr, scr, lane, gw, NGW);
        for (int z = 0; z < 3; ++z) tr_mat(0, w_branch + (size_t)((3 - z) % 3) * 1024 * 2048, nullptr, 1024, 2048, 2048, WBR_T + (size_t)z * 2048 * 1024, 1024, nullptr, scr, lane, gw, NGW);
        tr_mat(0, w_o, w_o, 2048, 2048, 2048, WO_T, DM, nullptr, scr, lane, gw, NGW);
        for (int m = gw; m < S; m += NGW) ln_row(x + (size_t)m * DM, ln_emb_g, ln_emb_b, nullptr, H0B + (size_t)m * DM, STATS + 2 * m, lane);
        const int gt = bid * 512 + tid, NGT = G * 512;
        for (int i = gt; i < S * 32; i += NGT) { const int s = i >> 5, f = i & 31;
            const double invf = exp(-(double)f * (9.210340371976184 / 32.0));
            const double t = (double)positions[s] * invf * 0.15915494309189535; const float fr = (float)(t - rint(t));
            COS[i] = __builtin_amdgcn_cosf(fr); SIN[i] = __builtin_amdgcn_sinf(fr); }
        for (int i = gt; i < 2048; i += NGT) { const int z = i >> 10, w = i & 1023; const float l0 = lb_logits[(z * 2 + 0) * 1024 + w], l1 = lb_logits[(z * 2 + 1) * 1024 + w]; LB[i] = 1.f / (1.f + __expf(l1 - l0)); }
        for (int i = gt; i < NMEM * DM / 4; i += NGT) ((u32x2*)MEMB)[i] = pk4(((const f32x4*)memp)[i]);
        __syncthreads();
    }
    SEAM(0);
    if (IN(1)) {
        {   pg8::Sched Sc; Sc.init(S, NINP, 1, G, bid); Sc.a_z = 0; Sc.A0 = (const char*)H0B; Sc.B = (const char*)WIN_T; Sc.a_pm = 256L * DM * 2; Sc.a_pn = 0; Sc.b_pn = 256L * DM * 2; Sc.b_z = 0;
            pg8::EpiP1 E{QH, VH, GF, GH, CQ, CKV, QM, GS, KR, SSQ, LB, COS, SIN};
            pg8::gemm_phase<pg8::EpiP1, true>(ldsl, DM, DM, DM, Sc, E); }
        {
            pg8::Sched Sc; Sc.init(NMEM, 1024, 1, G, bid); Sc.a_z = 0; Sc.A0 = (const char*)MEMB; Sc.B = (const char*)WKV_T; Sc.a_pm = 0; Sc.a_pn = 0; Sc.b_pn = 256L * DM * 2; Sc.b_z = 0;
            pg8::EpiStore E{KVM, 1024, 1.f};
            pg8::gemm_phase<pg8::EpiStore, true>(ldsl, DM, DM, DM, Sc, E); }
        {
            pg8::Sched Sc; Sc.init(1024, NMEM, 1, G, bid); Sc.a_z = 0; Sc.A0 = (const char*)(WKV_T + (size_t)1024 * DM); Sc.B = (const char*)MEMB; Sc.a_pm = 256L * DM * 2; Sc.a_pn = 0; Sc.b_pn = 0; Sc.b_z = 0;
            pg8::EpiStore E{VMT, 256, 1.f};
            pg8::gemm_phase<pg8::EpiStore, true>(ldsl, DM, DM, DM, Sc, E); }
    }
    SEAM(1);
    if (IN(2)) {
#ifndef DBG_SKIPG2
        {   pg8::Sched Sc; Sc.init(S, 1536, 1, G, bid); Sc.a_z = 0; Sc.A0 = (const char*)CQ; Sc.B = (const char*)WUQ_T; Sc.a_pm = 256L * 512 * 2; Sc.a_pn = 0; Sc.b_pn = 256L * 512 * 2; Sc.b_z = 0;
            pg8::EpiQ E{QB, SSQ, COS, SIN};
            pg8::gemm_phase<pg8::EpiQ, true>(ldsl, 512, 512, 512, Sc, E); }
        {   pg8::Sched Sc; Sc.init(S, 2048, 1, G, bid); Sc.a_z = 0; Sc.A0 = (const char*)CKV; Sc.B = (const char*)WUKV_T; Sc.a_pm = 256L * 512 * 2; Sc.a_pn = 0; Sc.b_pn = 256L * 512 * 2; Sc.b_z = 0;
            pg8::EpiKV E{KB, VB, SSQ + (size_t)S * 8};
            pg8::gemm_phase<pg8::EpiKV, true>(ldsl, 512, 512, 512, Sc, E); }
        {
            pg8::Sched Sc; Sc.init(S, 1024, 1, G, bid); Sc.a_z = 0; Sc.A0 = (const char*)QM; Sc.B = (const char*)KVM; Sc.a_pm = 256L * 1024 * 2; Sc.a_pn = 256 * 2; Sc.b_pn = 256 * 2; Sc.b_z = 0;
            pg8::EpiStore E{SC, 1024, 0.0625f};
            pg8::gemm_phase<pg8::EpiStore, true>(ldsl, 1024, 1024, 256, Sc, E); }
#endif
#ifdef DBG_COPY
        { const size_t gt2 = (size_t)bid * 512 + tid, NGT2 = (size_t)G * 512;
          for (size_t j = gt2; j < 16777216; j += NGT2) { HS[j] = GF[j]; HS[16777216 + j] = VH[j & 8388607]; }
          for (size_t j = gt2; j < 262144; j += NGT2) DVEC[j] = 1.f; }
#else
        {
            bf16_t* KwT = (bf16_t*)lds;
            bf16_t* VT = (bf16_t*)(lds + 18432);
            float* TOT = (float*)(lds + 36864);
            const int ch = tid & 127, sb = tid >> 7;
            for (int it = bid; it < 2048; it += G) {
                const int z = it >> 10, h = (it >> 7) & 7, c = it & 127, t0 = 64 * c;
                __syncthreads();
                float gr[16], ar[16]; float acc_a = 0.f;
#pragma unroll
                for (int r = 0; r < 16; ++r) { const int tau = 16 * sb + r, t = z ? (t0 + 63 - tau) : (t0 + tau);
                    const float g = bf2f(GF[(size_t)z * S * 1024 + (size_t)t * 1024 + 128 * h + ch]); acc_a += g; gr[r] = g; ar[r] = acc_a; }
                TOT[sb * 128 + ch] = acc_a;
#pragma unroll
                for (int j = 0; j < 2; ++j) { const int q = tid + 512 * j, tau = q >> 4, vc0 = (q & 15) * 8, t = z ? (t0 + 63 - tau) : (t0 + tau);
                    const bf16x8 v = *(const bf16x8*)(VH + (size_t)t * 1024 + 128 * h + vc0);
#pragma unroll
                    for (int e = 0; e < 8; ++e) VT[(vc0 + e) * 72 + tau] = (bf16_t)v[e]; }
                __syncthreads();
                float later = 0.f;
#pragma unroll
                for (int i2 = 1; i2 < 4; ++i2) if (i2 > sb) later += TOT[i2 * 128 + ch];
                if (sb == 0) DVEC[(size_t)it * 128 + ch] = __expf(acc_a + later);
#pragma unroll
                for (int r = 0; r < 16; ++r) { const float k = 1.f - __expf(gr[r]); KwT[ch * 72 + 16 * sb + r] = (bf16_t)f2bf(k * __expf((acc_a - ar[r]) + later)); }
                __syncthreads();
                f32x4 acc[8];
#pragma unroll
                for (int nb = 0; nb < 8; ++nb) acc[nb] = (f32x4){0.f, 0.f, 0.f, 0.f};
#pragma unroll
                for (int ks = 0; ks < 2; ++ks) { const bf16x8 A = *(const bf16x8*)(KwT + (16 * wave + (lane & 15)) * 72 + 32 * ks + (lane >> 4) * 8);
#pragma unroll
                    for (int nb = 0; nb < 8; ++nb) { const bf16x8 Bv = *(const bf16x8*)(VT + (16 * nb + (lane & 15)) * 72 + 32 * ks + (lane >> 4) * 8);
                        acc[nb] = __builtin_amdgcn_mfma_f32_16x16x32_bf16(A, Bv, acc[nb], 0, 0, 0); } }
                bf16_t* hs = HS + (size_t)it * 16384;
#pragma unroll
                for (int nb = 0; nb < 8; ++nb) *(u32x2*)(hs + (16 * nb + (lane & 15)) * 128 + 16 * wave + (lane >> 4) * 4) = pk4(acc[nb]);
            }
            __syncthreads();
        }
#endif
    }
    SEAM(2);
    if (IN(3)) {
        {
            const int gt = bid * 512 + tid, NGT = G * 512;
            for (int p = gt; p < 16 * 8192; p += NGT) { const int zh = p >> 13, e2 = p & 8191, z = zh >> 3, kch = (2 * e2) & 127;
                float s0 = 0.f, s1 = 0.f;
#pragma unroll 4
                for (int n = 0; n < 128; ++n) { const int c = z ? (127 - n) : n; const size_t it = (size_t)zh * 128 + c;
                    unsigned* pp = (unsigned*)(HS + it * 16384 + 2 * e2); const unsigned uu = *pp; const float d0 = DVEC[it * 128 + kch], d1 = DVEC[it * 128 + kch + 1];
                    *pp = cvt_pk_bf16(s0, s1);
                    s0 = d0 * s0 + __uint_as_float(uu << 16); s1 = d1 * s1 + __uint_as_float(uu & 0xffff0000u); } }
        }
        {
            for (int r = gw; r < S * 4; r += NGW) { const u32x2 w = *(const u32x2*)(SC + (size_t)r * 256 + 4 * lane); f32x4 v = unpk4(w);
                const float mx = wave_max(fmaxf(fmaxf(v[0], v[1]), fmaxf(v[2], v[3])));
#pragma unroll
                for (int e = 0; e < 4; ++e) v[e] = __expf(v[e] - mx);
                const float sm = wave_sum((v[0] + v[1]) + (v[2] + v[3])); const float inv = 1.f / sm;
                *(u32x2*)(PM + (size_t)r * 256 + 4 * lane) = pk4(v * inv); }
        }
        __syncthreads();
        for (int un = bid; un < 256; un += G) { const int h = un & 7, qb = un >> 3;
            mla::attn_unit(QB + (size_t)qb * 256 * 1536 + 192 * h, KB + 128 * h, KR, VB + 128 * h, YA + (size_t)qb * 256 * 1024 + 128 * h, S, (char*)lds); }
    }
    SEAM(3);
    if (IN(4)) {
        {   pg8::Sched Sc; Sc.init(S, 1024, 1, G, bid); Sc.a_z = 0; Sc.A0 = (const char*)PM; Sc.B = (const char*)VMT; Sc.a_pm = 256L * 1024 * 2; Sc.a_pn = 256 * 2; Sc.b_pn = 256L * 256 * 2; Sc.b_z = 0;
            pg8::EpiStore E{YM, 1024, 1.f};
            pg8::gemm_phase<pg8::EpiStore, true>(ldsl, 1024, 256, 256, Sc, E); }
        {
            bf16_t* QT = (bf16_t*)lds;
            bf16_t* KBt = (bf16_t*)(lds + 17408);
            bf16_t* KHT = (bf16_t*)(lds + 34816);
            bf16_t* VT = (bf16_t*)(lds + 53248);
            bf16_t* ST = (bf16_t*)(lds + 71680);
            float* O = (float*)(lds + 106496);
            float* Dd = (float*)(lds + 139264);
            bf16_t* PW = (bf16_t*)(lds + 141312) + wave * 256;
            const int ch = tid & 127, sb = tid >> 7, l15 = lane & 15, l4 = lane >> 4;
            for (int it = bid; it < 1024; it += G) {
                const int h = it >> 7, c = it & 127, t0 = 64 * c;
#pragma unroll 1
                for (int z = 0; z < 2; ++z) {
                    __syncthreads();
                    {   float gr[16], ar[16]; float aa = 0.f;
#pragma unroll
                        for (int r = 0; r < 16; ++r) { const int tau = 16 * sb + r, t = z ? (t0 + 63 - tau) : (t0 + tau);
                            const float g = bf2f(GF[(size_t)z * S * 1024 + (size_t)t * 1024 + 128 * h + ch]); aa += g; gr[r] = g; ar[r] = aa; }
                        Dd[sb * 128 + ch] = __expf(aa);
#pragma unroll
                        for (int r = 0; r < 16; ++r) { const int tau = 16 * sb + r, t = z ? (t0 + 63 - tau) : (t0 + tau);
                            const float q = bf2f(QH[(size_t)t * 1024 + 128 * h + ch]); const float k = 1.f - __expf(gr[r]);
                            QT[tau * 136 + ch] = (bf16_t)f2bf(q * __expf(ar[r])); KBt[tau * 136 + ch] = (bf16_t)f2bf(k * __expf(-ar[r])); KHT[ch * 72 + tau] = (bf16_t)f2bf(k * __expf(aa - ar[r])); }
                    }
#pragma unroll
                    for (int j = 0; j < 2; ++j) { const int q = tid + 512 * j, tau = q >> 4, vc0 = (q & 15) * 8, t = z ? (t0 + 63 - tau) : (t0 + tau);
                        const bf16x8 v = *(const bf16x8*)(VH + (size_t)t * 1024 + 128 * h + vc0);
#pragma unroll
                        for (int e = 0; e < 8; ++e) VT[(vc0 + e) * 72 + tau] = (bf16_t)v[e]; }
                    {   const bf16_t* hs = HS + ((size_t)(z * 8 + h) * 128 + c) * 16384;
#pragma unroll
                        for (int j = 0; j < 4; ++j) { const int q = tid + 512 * j, vcol = q >> 4, kc = (q & 15) * 8; *(u32x4*)(ST + vcol * 136 + kc) = *(const u32x4*)(hs + vcol * 128 + kc); } }
                    __syncthreads();
                    f32x4 sacc[8];
#pragma unroll
                    for (int nb = 0; nb < 8; ++nb) { const u32x2 w = *(const u32x2*)(ST + (16 * nb + l15) * 136 + 16 * wave + l4 * 4); sacc[nb] = unpk4(w); }
#pragma unroll 1
                    for (int i = 0; i < 4; ++i) {
                        bf16x8 Aq[4];
#pragma unroll
                        for (int ks = 0; ks < 4; ++ks) Aq[ks] = *(const bf16x8*)(QT + (16 * i + l15) * 136 + 32 * ks + l4 * 8);
                        f32x4 o = (f32x4){0.f, 0.f, 0.f, 0.f}, att = (f32x4){0.f, 0.f, 0.f, 0.f};
#pragma unroll
                        for (int ks = 0; ks < 4; ++ks) { const bf16x8 Bs = *(const bf16x8*)(ST + (16 * wave + l15) * 136 + 32 * ks + l4 * 8); o = __builtin_amdgcn_mfma_f32_16x16x32_bf16(Aq[ks], Bs, o, 0, 0, 0); }
#pragma unroll
                        for (int ks = 0; ks < 4; ++ks) { const bf16x8 Bk = *(const bf16x8*)(KBt + (16 * i + l15) * 136 + 32 * ks + l4 * 8); att = __builtin_amdgcn_mfma_f32_16x16x32_bf16(Aq[ks], Bk, att, 0, 0, 0); }
#pragma unroll
                        for (int j = 0; j < 4; ++j) { const int tr = l4 * 4 + j; PW[tr * 16 + l15] = (bf16_t)f2bf((l15 <= tr) ? att[j] : 0.f); }
                        LDS_WAIT();
                        bf16x8 Ap = (bf16x8){0, 0, 0, 0, 0, 0, 0, 0}, Bv = (bf16x8){0, 0, 0, 0, 0, 0, 0, 0}, Ak = (bf16x8){0, 0, 0, 0, 0, 0, 0, 0};
                        if (lane < 32) { Ap = *(const bf16x8*)(PW + l15 * 16 + l4 * 8); Bv = *(const bf16x8*)(VT + (16 * wave + l15) * 72 + 16 * i + l4 * 8); Ak = *(const bf16x8*)(KHT + (16 * wave + l15) * 72 + 16 * i + l4 * 8); }
                        o = __builtin_amdgcn_mfma_f32_16x16x32_bf16(Ap, Bv, o, 0, 0, 0);
#pragma unroll
                        for (int j = 0; j < 4; ++j) { const int tau = 16 * i + l4 * 4 + j, tt = z ? (63 - tau) : tau; float* op = O + tt * 128 + 16 * wave + l15; if (z == 0) *op = o[j]; else *op += o[j]; }
                        if (i < 3) {
                            const f32x4 dv = *(const f32x4*)(Dd + i * 128 + 16 * wave + l4 * 4);
#pragma unroll
                            for (int nb = 0; nb < 8; ++nb) { bf16x8 Bn = (bf16x8){0, 0, 0, 0, 0, 0, 0, 0}; if (lane < 32) Bn = *(const bf16x8*)(VT + (16 * nb + l15) * 72 + 16 * i + l4 * 8);
                                sacc[nb] = __builtin_amdgcn_mfma_f32_16x16x32_bf16(Ak, Bn, sacc[nb] * dv, 0, 0, 0); }
                            __syncthreads();
#pragma unroll
                            for (int nb = 0; nb < 8; ++nb) *(u32x2*)(ST + (16 * nb + l15) * 136 + 16 * wave + l4 * 4) = pk4(sacc[nb]);
                            __syncthreads();
                        }
                    }
                }
                __syncthreads();
#pragma unroll 1
                for (int k2 = 0; k2 < 8; ++k2) { const int tt = 8 * wave + k2; const float v0 = O[tt * 128 + lane], v1 = O[tt * 128 + 64 + lane];
                    const float r = rsqrtf(wave_sum(v0 * v0 + v1 * v1) * (1.f / 128.f) + RMS_EPS); const size_t base = (size_t)(t0 + tt) * 1024 + 128 * h;
                    YH[base + lane] = (bf16_t)f2bf(v0 * r * hg_norm_g[lane] * bf2f(GH[base + lane]));
                    YH[base + 64 + lane] = (bf16_t)f2bf(v1 * r * hg_norm_g[64 + lane] * bf2f(GH[base + 64 + lane])); }
            }
            __syncthreads();
        }
    }
    SEAM(4);
    if (IN(5)) {
        pg8::Sched Sc; Sc.init(S, DM, 3, G, bid); Sc.A0 = (const char*)YH; Sc.a_z = 16L * 1024 * 1024; Sc.B = (const char*)WBR_T; Sc.a_pm = 256L * 1024 * 2; Sc.a_pn = 0; Sc.b_pn = 256L * 1024 * 2; Sc.b_z = 2048L * 1024 * 2;
        pg8::EpiMerge E{GS, MERGED, MERGEDB};
        pg8::gemm_phase<pg8::EpiMerge, true>(ldsl, 1024, 1024, 1024, Sc, E);
    }
    SEAM(5);
    if (IN(6)) {
        pg8::Sched Sc; Sc.init(S, DM, 1, G, bid); Sc.a_z = 0; Sc.A0 = (const char*)MERGEDB; Sc.B = (const char*)WO_T; Sc.a_pm = 256L * DM * 2; Sc.a_pn = 0; Sc.b_pn = 256L * DM * 2; Sc.b_z = 0;
        pg8::EpiWo E{x, STATS, ln_emb_g, ln_emb_b, R1};
        pg8::gemm_phase<pg8::EpiWo, true>(ldsl, DM, DM, DM, Sc, E);
    }
    SEAM(6);
    if (IN(7)) {
        for (int m = gw; m < S; m += NGW) ln_row(R1 + (size_t)m * DM, ln1_g, ln1_b, R1 + (size_t)m * DM, H1B + (size_t)m * DM, nullptr, lane);
        float* scr = (float*)lds + wave * (64 * 65);
        tr_mat(3, w_gate, w_up, DM, DFF, 2 * DFF, WGU_T, DM, nullptr, scr, lane, gw, NGW);
        tr_mat(0, w_down, w_down, DFF, DM, DM, WD_T, LDACT, nullptr, scr, lane, gw, NGW);
        __syncthreads();
    }
    SEAM(7);
    if (IN(8)) {
        pg8::Sched Sc; Sc.init(S, 2 * DFF, 1, G, bid); Sc.a_z = 0; Sc.A0 = (const char*)H1B; Sc.B = (const char*)WGU_T; Sc.a_pm = 256L * DM * 2; Sc.a_pn = 0; Sc.b_pn = 256L * DM * 2; Sc.b_z = 0;
        pg8::EpiGU E{ACT};
        pg8::gemm_phase<pg8::EpiGU, true>(ldsl, DM, DM, DM, Sc, E);
    }
    SEAM(8);
    if (IN(9)) {
        pg8::Sched Sc; Sc.init(S, DM, 1, G, bid); Sc.a_z = 0; Sc.A0 = (const char*)ACT; Sc.B = (const char*)WD_T; Sc.a_pm = 256L * LDACT * 2; Sc.a_pn = 0; Sc.b_pn = 256L * LDACT * 2; Sc.b_z = 0;
        pg8::EpiDown E{R1, out};
        pg8::gemm_phase<pg8::EpiDown, true>(ldsl, LDACT, LDACT, DFF, Sc, E);
    }
    SEAM(9);
    if (IN(10)) {
        for (int m = gw; m < S; m += NGW) ln_row(out + (size_t)m * DM, ln2_g, ln2_b, out + (size_t)m * DM, nullptr, nullptr, lane);
    }
#ifdef DBG_STOP
    {
        asm volatile("s_waitcnt vmcnt(0)" ::: "memory"); __threadfence(); grid.sync(); __builtin_amdgcn_fence(__ATOMIC_ACQUIRE, "agent"); asm volatile("s_waitcnt vmcnt(0)" ::: "memory");
        const size_t NO = (size_t)S * DM; const size_t gt = (size_t)bid * 512 + tid, NGT = (size_t)G * 512;
#define DB(ptr, n) for (size_t j = i; j < (size_t)(n); j += NO) acc += bf2f(((const bf16_t*)(ptr))[j]);
#define DF(ptr, n) for (size_t j = i; j < (size_t)(n); j += NO) acc += ((const float*)(ptr))[j];
        for (size_t i = gt; i < NO; i += NGT) { float acc = 0.f;
#if DBG_STOP == 0
            DB(WIN_T, 27787264) DB(H0B, 16777216) DB(WUQ_T, 786432) DB(WUKV_T, 1048576) DB(WKV_T, 4194304) DB(MEMB, 524288) DB(WBR_T, 6291456) DB(WO_T, 4194304) DF(STATS, 16384) DF(LB, 2048) DF(COS, 262144) DF(SIN, 262144)
#elif DBG_STOP == 1
            DB(QH, 8388608) DB(VH, 8388608) DB(GF, 16777216) DB(GH, 8388608) DB(CQ, 4194304) DB(CKV, 4194304) DB(QM, 8388608) DB(GS, 50331648) DB(KR, 524288) DB(KVM, 262144) DB(VMT, 262144) DF(SSQ, 131072)
#elif DBG_STOP == 2
            DB(QB, 12582912) DB(KB, 8388608) DB(VB, 8388608) DB(SC, 8388608) DB(HS, 33554432) DF(DVEC, 262144)
#elif DBG_STOP == 3
            DB(HS, 33554432) DB(PM, 8388608) DB(YA, 8388608)
#elif DBG_STOP == 4
            DB(YM, 8388608) DB(YH, 8388608)
#elif DBG_STOP == 5
            DB(MERGEDB, 16777216) DF(MERGED, 16777216)
#elif DBG_STOP == 6
            DF(R1, 16777216)
#elif DBG_STOP == 7
            DF(R1, 16777216) DB(H1B, 16777216) DB(WGU_T, 23068672) DB(WD_T, 11534336)
#elif DBG_STOP == 8
            DB(ACT, 46137344)
#endif
            out[i] = acc; }
    }
#endif
}

extern "C" void kernel_launch(void* const* d_in, const int* in_sizes, int n_in, void* d_out, int out_size, void* d_ws, size_t ws_size, hipStream_t stream) {
    static int grid = 0;
    if (grid == 0) {
        if (n_in != 22 || out_size != S * DM || ws_size < WS_END) { fprintf(stderr, "kernel_launch: unexpected shapes (n_in %d out %d ws %zu, need %zu)\n", n_in, out_size, ws_size, (size_t)WS_END); grid = -1; return; }
        int dev = 0, cus = 0, per_cu = 0;
        hipGetDevice(&dev); hipDeviceGetAttribute(&cus, hipDeviceAttributeMultiprocessorCount, dev);
        if (hipFuncSetAttribute((const void*)mega, hipFuncAttributeMaxDynamicSharedMemorySize, LDS_BYTES) != hipSuccess) { fprintf(stderr, "kernel_launch: hipFuncSetAttribute failed\n"); grid = -1; return; }
        if (hipOccupancyMaxActiveBlocksPerMultiprocessor(&per_cu, (const void*)mega, 512, LDS_BYTES) != hipSuccess || per_cu < 1) { fprintf(stderr, "kernel_launch: occupancy query failed (%d)\n", per_cu); per_cu = 1; (void)hipGetLastError(); }
        grid = cus * 1;
    }
    if (grid < 0) return;
    Args a{};
    for (int i = 0; i < 22; ++i) a.in[i] = (const float*)d_in[i];
    a.out = (float*)d_out; a.ws = (unsigned char*)d_ws; a.ph_lo = 0; a.ph_hi = 11;
#ifdef DBG_STOP
    a.ph_hi = DBG_STOP + 1;
#endif
    void* args[] = {&a};
#ifdef PROBE_K
    {   Args b = a; b.ph_hi = PROBE_K + 1; void* bargs[] = {&b};
        (void)hipLaunchCooperativeKernel((const void*)mega, dim3(grid), dim3(512), bargs, LDS_BYTES, stream); }
#endif
    hipError_t e = hipLaunchCooperativeKernel((const void*)mega, dim3(grid), dim3(512), args, LDS_BYTES, stream);
    if (e != hipSuccess) fprintf(stderr, "cooperative launch failed: %s (grid %d)\n", hipGetErrorString(e), grid);
}
```

```cpp
#include <hip/hip_runtime.h>
#include <hip/hip_cooperative_groups.h>
#include <cstdio>
#include <cstdint>
namespace cg = cooperative_groups;

#define LAS __attribute__((address_space(3)))
typedef unsigned short bf16_t;
typedef short bf16x8 __attribute__((ext_vector_type(8)));
typedef short s16x4 __attribute__((ext_vector_type(4)));
typedef float f32x4 __attribute__((ext_vector_type(4)));
typedef float f32x16 __attribute__((ext_vector_type(16)));
typedef unsigned u32x4 __attribute__((ext_vector_type(4)));
typedef unsigned u32x2 __attribute__((ext_vector_type(2)));

constexpr int S = 8192, DM = 2048, NMEM = 256, DFF = 5632;
constexpr int LDACT = 5696;
constexpr int NINP = 13568;
constexpr float ALPHA = 1.189207115002721f;
constexpr float LN_EPS = 1e-5f, RMS_EPS = 1e-6f;

constexpr size_t MiB = 1u << 20;
constexpr size_t WS_SSQ = 262144, WS_STATS = 65536, WS_LB = 131072;
constexpr size_t WS_COS = 1 * MiB, WS_SIN = 2 * MiB, WS_DVEC = 3 * MiB;
constexpr size_t WS_WIN_T = 4 * MiB, WS_H0B = 57 * MiB;
constexpr size_t WS_WUQ_T = 89 * MiB, WS_WUKV_T = 89 * MiB + 1536 * 1024, WS_WKV_T = 92 * MiB + 512 * 1024, WS_MEMB = 100 * MiB + 512 * 1024;
constexpr size_t WS_KVM = 102 * MiB, WS_VMT = 102 * MiB + 512 * 1024, WS_KR = 103 * MiB;
constexpr size_t WS_QH = 104 * MiB, WS_VH = 120 * MiB, WS_GF = 136 * MiB, WS_GH = 168 * MiB;
constexpr size_t WS_CQ = 184 * MiB, WS_CKV = 192 * MiB, WS_QM = 200 * MiB, WS_GS = 216 * MiB;
constexpr size_t WS_HS = 312 * MiB, WS_YA = 84 * MiB, WS_WBR_T = 393 * MiB, WS_WO_T = 405 * MiB, WS_END = 413 * MiB;
constexpr size_t WS_KB = 4 * MiB, WS_VB = 20 * MiB, WS_QB = 36 * MiB, WS_SC = 60 * MiB;
constexpr size_t WS_PM = 184 * MiB;
constexpr size_t WS_YH = 52 * MiB, WS_YM = 68 * MiB;
constexpr size_t WS_MERGED = 104 * MiB, WS_MERGEDB = 168 * MiB;
constexpr size_t WS_R1 = 104 * MiB, WS_H1B = 168 * MiB;
constexpr size_t WS_WGU_T = 312 * MiB, WS_WD_T = 356 * MiB;
constexpr size_t WS_ACT = 216 * MiB;

constexpr int LDS_BYTES = 150 * 1024;

__device__ __forceinline__ float bf2f(bf16_t v) { return __uint_as_float((unsigned)v << 16); }
__device__ __forceinline__ unsigned f2bf(float f) { unsigned u = __float_as_uint(f); return (u + 0x7fffu + ((u >> 16) & 1u)) >> 16; }
__device__ __forceinline__ unsigned pk2(float lo, float hi) { return f2bf(lo) | (f2bf(hi) << 16); }
typedef __bf16 bf16x2_t __attribute__((ext_vector_type(2)));
typedef float f32x2_t __attribute__((ext_vector_type(2)));
__device__ __forceinline__ unsigned cvt_pk_bf16(float lo, float hi) { f32x2_t v = {lo, hi}; bf16x2_t b = __builtin_convertvector(v, bf16x2_t); return __builtin_bit_cast(unsigned, b); }
__device__ __forceinline__ u32x2 pk4(f32x4 v) { u32x2 w; w.x = cvt_pk_bf16(v[0], v[1]); w.y = cvt_pk_bf16(v[2], v[3]); return w; }
__device__ __forceinline__ f32x4 unpk4(u32x2 w) { f32x4 v; v[0] = __uint_as_float(w.x << 16); v[1] = __uint_as_float(w.x & 0xffff0000u); v[2] = __uint_as_float(w.y << 16); v[3] = __uint_as_float(w.y & 0xffff0000u); return v; }
__device__ __forceinline__ float wave_sum(float v) {
#pragma unroll
    for (int o = 1; o < 64; o <<= 1) v += __shfl_xor(v, o);
    return v;
}
__device__ __forceinline__ float wave_max(float v) {
#pragma unroll
    for (int o = 1; o < 64; o <<= 1) v = fmaxf(v, __shfl_xor(v, o));
    return v;
}
__device__ __forceinline__ float sigmoidf_(float v) { return __builtin_amdgcn_rcpf(1.f + __expf(-v)); }
#define LDS_WAIT() asm volatile("s_waitcnt lgkmcnt(0)" ::: "memory")

namespace pg8 {
constexpr int BM = 256, BK = 64, HALF = 128, HTB = HALF * BK * 2, STAGE_BYTES = 8 * HTB, NXCD = 8, WGM = 8;
__host__ __device__ __forceinline__ int lds_byte(int r, int c) { const int st = (r >> 4) * 2 + (c >> 5), rr = r & 15, cc = c & 31, ob = rr * 64 + cc * 2; return st * 1024 + (ob ^ (((ob >> 9) & 1) << 5)); }
__host__ __device__ __forceinline__ void stage_rc(int b, int& R, int& C) { const int st = b / 1024, sb = b % 1024, swz = sb ^ (((sb >> 9) & 1) << 5); R = (st >> 1) * 16 + swz / 64; C = (st & 1) * 32 + (swz % 64) / 2; }

struct Unit { int pm, pn, z; };
struct Sched {
    int nM, nN, nZ, nwg, G, c;
    const char* A0; const char* B;
    long a_pm, a_pn, a_z, b_pn, b_z;
    __device__ __forceinline__ void init(int M, int N, int nZ_, int G_, int c_) { nM = M / BM; nN = N / BM; nZ = nZ_; nwg = nM * nN; G = G_; c = c_; }
    __device__ __forceinline__ bool next(int i, Unit& u) const {
        const int z = i % nZ; const long L = (long)(i / nZ) * G + c; if (L >= nwg) return false;
        int wgid = (int)L; { const int q = nwg / NXCD, r = nwg % NXCD, xcd = wgid % NXCD, off = wgid / NXCD; wgid = (xcd < r ? xcd * (q + 1) : r * (q + 1) + (xcd - r) * q) + off; }
        const int nig = WGM * nN, gid = wgid / nig, fm = gid * WGM, gsz = (nM - fm) < WGM ? (nM - fm) : WGM;
        u.pm = fm + ((wgid % nig) % gsz); u.pn = (wgid % nig) / gsz; u.z = z; return true;
    }
    __device__ __forceinline__ const char* aptr(const Unit& u) const { return A0 + u.pm * a_pm + u.pn * a_pn + u.z * a_z; }
    __device__ __forceinline__ const char* bptr(const Unit& u) const { return B + u.pn * b_pn + u.z * b_z; }
};

template <class Epi, bool ALIGN_EPI>
__device__ __forceinline__ void gemm_phase(LAS unsigned char* lds, const int lda, const int ldb, const int K, const Sched& S, const Epi& E) {
    const int tid = threadIdx.x, wid = __builtin_amdgcn_readfirstlane(tid >> 6), lane = tid & 63, wr = wid >> 2, wc = wid & 3, fr = lane & 15, fq = lane >> 4;
    const int nt = K / BK;
    unsigned voffA[2], voffB[2];
#pragma unroll
    for (int i = 0; i < 2; ++i) { int R, C; stage_rc(tid * 16 + i * 8192, R, C); voffA[i] = (unsigned)(R * lda + C) * 2u; voffB[i] = (unsigned)(R * ldb + C) * 2u; }
    const size_t kstep = (size_t)(BK * 2);
    const size_t hstepA = (size_t)HALF * lda * 2, hstepB = (size_t)HALF * ldb * 2;
    const unsigned ldsw = (unsigned)wid * 1024u;
    const int aoff = lds_byte(wr * 64 + fr, fq * 8), boff = lds_byte(wc * 32 + fr, fq * 8);
#define PG8_SA(b, h) (((b) * 2 + (h)) * HTB)
#define PG8_SB(b, h) ((4 + (b) * 2 + (h)) * HTB)
#define PG8_STAGE(bufoff, gbase, voff) do { _Pragma("unroll") for (int _i = 0; _i < 2; ++_i) \
        __builtin_amdgcn_global_load_lds((const unsigned*)((const char*)(gbase) + (voff)[_i]), (LAS unsigned*)(lds + (bufoff) + ldsw + _i * 8192), 16, 0, 0); } while (0)
#define PG8_LDA(dst, b, h) do { _Pragma("unroll") for (int m = 0; m < 4; ++m) _Pragma("unroll") for (int k = 0; k < 2; ++k) dst[m][k] = *(const LAS bf16x8*)(lds + PG8_SA(b, h) + aoff + m * 2048 + k * 1024); } while (0)
#define PG8_LDB(dst, b, h) do { _Pragma("unroll") for (int n = 0; n < 2; ++n) _Pragma("unroll") for (int k = 0; k < 2; ++k) dst[n][k] = *(const LAS bf16x8*)(lds + PG8_SB(b, h) + boff + n * 2048 + k * 1024); } while (0)
#define PG8_MMA(ai, bj, At, Bt) do { __builtin_amdgcn_s_setprio(1); _Pragma("unroll") for (int m = 0; m < 4; ++m) _Pragma("unroll") for (int n = 0; n < 2; ++n) _Pragma("unroll") for (int k = 0; k < 2; ++k) \
        acc[ai][bj][m][n] = __builtin_amdgcn_mfma_f32_16x16x32_bf16(Bt[n][k], At[m][k], acc[ai][bj][m][n], 0, 0, 0); __builtin_amdgcn_s_setprio(0); } while (0)
#define PG8_WAIT_V(n) asm volatile("s_waitcnt vmcnt(" #n ")" ::: "memory")
#define PG8_WAIT_L(n) asm volatile("s_waitcnt lgkmcnt(" #n ")" ::: "memory")
#define PG8_BAR __builtin_amdgcn_s_barrier()
#define PG8_SCHED __builtin_amdgcn_sched_barrier(0)
    Unit cur, nxt; int ui = 0;
    if (!S.next(0, cur)) return;
    f32x4 acc[2][2][4][2];
#pragma unroll
    for (int a = 0; a < 2; ++a)
#pragma unroll
        for (int b = 0; b < 2; ++b)
#pragma unroll
            for (int m = 0; m < 4; ++m)
#pragma unroll
                for (int n = 0; n < 2; ++n) acc[a][b][m][n] = (f32x4){0.f, 0.f, 0.f, 0.f};
    bf16x8 At[4][2], B0[2][2], B1[2][2];
    const char* cA = S.aptr(cur); const char* cB = S.bptr(cur);
    PG8_STAGE(PG8_SB(0, 0), cB, voffB); PG8_STAGE(PG8_SB(0, 1), cB + hstepB, voffB); PG8_STAGE(PG8_SA(0, 0), cA, voffA); PG8_STAGE(PG8_SA(0, 1), cA + hstepA, voffA);
    if (wr == 1) PG8_BAR;
    PG8_WAIT_V(2); PG8_BAR;
    PG8_STAGE(PG8_SB(1, 0), cB + kstep, voffB); PG8_STAGE(PG8_SA(1, 0), cA + kstep, voffA); PG8_STAGE(PG8_SB(1, 1), cB + hstepB + kstep, voffB);
    PG8_WAIT_V(6); PG8_BAR;
    for (;;) {
        const bool has_next = S.next(ui + 1, nxt);
        const char* nA = has_next ? S.aptr(nxt) : cA; const char* nB = has_next ? S.bptr(nxt) : cB;
        for (int t = 0; t < nt; t += 2) {
            const bool last = (t == nt - 2);
            const char* a1 = cA + (size_t)(t + 1) * kstep;
            const char* a2 = last ? nA : cA + (size_t)(t + 2) * kstep; const char* b2 = last ? nB : cB + (size_t)(t + 2) * kstep;
            const char* a3 = a2 + kstep; const char* b3 = b2 + kstep;
            PG8_LDB(B0, 0, 0); PG8_LDB(B1, 0, 1); PG8_SCHED; PG8_LDA(At, 0, 0); PG8_STAGE(PG8_SA(1, 1), a1 + hstepA, voffA);
            PG8_WAIT_V(8); PG8_WAIT_L(0); PG8_BAR; PG8_MMA(0, 0, At, B0); PG8_MMA(0, 1, At, B1); PG8_BAR; PG8_SCHED;
            PG8_LDA(At, 0, 1); PG8_STAGE(PG8_SB(0, 0), b2, voffB); PG8_STAGE(PG8_SB(0, 1), b2 + hstepB, voffB); PG8_STAGE(PG8_SA(0, 0), a2, voffA);
            PG8_WAIT_V(8); PG8_WAIT_L(0); PG8_BAR; PG8_MMA(1, 0, At, B0); PG8_MMA(1, 1, At, B1); PG8_BAR; PG8_SCHED;
            PG8_LDB(B0, 1, 0); PG8_LDB(B1, 1, 1); PG8_SCHED; PG8_LDA(At, 1, 0); PG8_STAGE(PG8_SA(0, 1), a2 + hstepA, voffA);
            PG8_WAIT_V(8); PG8_WAIT_L(0); PG8_BAR; PG8_MMA(0, 0, At, B0); PG8_MMA(0, 1, At, B1); PG8_BAR; PG8_SCHED;
            PG8_LDA(At, 1, 1); PG8_STAGE(PG8_SB(1, 0), b3, voffB); PG8_STAGE(PG8_SB(1, 1), b3 + hstepB, voffB); PG8_STAGE(PG8_SA(1, 0), a3, voffA);
            PG8_WAIT_V(8); PG8_WAIT_L(0); PG8_BAR; PG8_MMA(1, 0, At, B0); PG8_MMA(1, 1, At, B1); PG8_BAR; PG8_SCHED;
        }
        if constexpr (ALIGN_EPI) { if (wr == 0) PG8_BAR; }
        E(acc, cur, wr, wc, fr, fq);
        if (!has_next) break;
#pragma unroll
        for (int a = 0; a < 2; ++a)
#pragma unroll
            for (int b = 0; b < 2; ++b)
#pragma unroll
                for (int m = 0; m < 4; ++m)
#pragma unroll
                    for (int n = 0; n < 2; ++n) acc[a][b][m][n] = (f32x4){0.f, 0.f, 0.f, 0.f};
        cur = nxt; cA = nA; cB = nB; ++ui;
        if constexpr (ALIGN_EPI) { if (wr == 1) PG8_BAR; }
    }
    PG8_WAIT_V(0);
    if constexpr (!ALIGN_EPI) { if (wr == 0) PG8_BAR; }
    PG8_BAR;
#undef PG8_SA
#undef PG8_SB
#undef PG8_STAGE
#undef PG8_LDA
#undef PG8_LDB
#undef PG8_MMA
#undef PG8_WAIT_V
#undef PG8_WAIT_L
#undef PG8_BAR
#undef PG8_SCHED
}

#define EPI_ARGS const f32x4 (&acc)[2][2][4][2], const Unit& u, int wr, int wc, int fr, int fq
#define EPI_ROWS for (int ai = 0; ai < 2; ++ai) for (int m = 0; m < 4; ++m)
#define EPI_COLS for (int bj = 0; bj < 2; ++bj) for (int n = 0; n < 2; ++n)

struct EpiStore {
    bf16_t* O; int ldc; float scale;
    __device__ __forceinline__ void operator()(EPI_ARGS) const {
        const int row0 = u.pm * BM + wr * 64 + fr, col0 = u.pn * BM + wc * 32 + 4 * fq;
#pragma unroll
        EPI_ROWS { bf16_t* rp = O + (size_t)(row0 + ai * HALF + m * 16) * ldc + col0;
#pragma unroll
            EPI_COLS { *(u32x2*)(rp + bj * HALF + n * 16) = pk4(acc[ai][bj][m][n] * scale); } }
    }
};

struct EpiP1 {
    bf16_t *QH, *VH, *GF, *GH, *CQ, *CKV, *QM, *GS, *KR; float* SSQ; const float *LB, *COS, *SIN;
    __device__ __forceinline__ void operator()(EPI_ARGS) const {
        const int pn = u.pn; const int row0 = u.pm * BM + wr * 64 + fr; const int ct = wc * 32 + 4 * fq;
        if (pn == 52) {
            if (wc < 2) {
                const int i0 = 16 * wc + 4 * fq;
#pragma unroll
                EPI_ROWS { const int row = row0 + ai * HALF + m * 16;
                    const f32x4 cs = *(const f32x4*)(COS + (size_t)row * 32 + i0), sn = *(const f32x4*)(SIN + (size_t)row * 32 + i0);
                    const f32x4 x1 = acc[ai][0][m][0], x2 = acc[ai][0][m][1];
                    const f32x4 o1 = x1 * cs - x2 * sn, o2 = x2 * cs + x1 * sn;
                    bf16_t* rp = KR + (size_t)row * 64 + 32 * wc + 4 * fq;
                    *(u32x2*)(rp) = pk4(o1); *(u32x2*)(rp + 16) = pk4(o2); }
            }
            return;
        }
        int op, ld, c0, ssq = -1; bf16_t* dst; const float* lbp = nullptr;
        if (pn < 4) { op = 1; dst = QH; ld = 1024; c0 = 256 * pn; }
        else if (pn < 8) { op = 0; dst = VH; ld = 1024; c0 = 256 * (pn - 4); }
        else if (pn < 16) { const int z = (pn >= 12) ? 1 : 0; op = 3; dst = GF + (size_t)z * S * 1024; ld = 1024; c0 = 256 * ((pn - 8) & 3); lbp = LB + z * 1024 + c0 + ct; }
        else if (pn < 20) { op = 2; dst = GH; ld = 1024; c0 = 256 * (pn - 16); }
        else if (pn < 22) { op = 0; dst = CQ; ld = 512; c0 = 256 * (pn - 20); ssq = 0; }
        else if (pn < 24) { op = 0; dst = CKV; ld = 512; c0 = 256 * (pn - 22); ssq = 1; }
        else if (pn < 28) { op = 0; dst = QM; ld = 1024; c0 = 256 * (pn - 24); }
        else { op = 2; dst = GS; ld = 6144; c0 = 256 * (pn - 28); }
        f32x4 lbv[2][2];
#pragma unroll
        EPI_COLS lbv[bj][n] = (op == 3) ? *(const f32x4*)(lbp + bj * HALF + n * 16) : (f32x4){0.f, 0.f, 0.f, 0.f};
#pragma unroll
        EPI_ROWS { const int row = row0 + ai * HALF + m * 16; bf16_t* rp = dst + (size_t)row * ld + c0 + ct; float ss = 0.f;
#pragma unroll
            EPI_COLS { f32x4 v = acc[ai][bj][m][n];
                if (op != 0) {
#pragma unroll
                    for (int e = 0; e < 4; ++e) { const float x = v[e]; const float sg = sigmoidf_(x);
                        float r = sg; if (op == 1) r = x * sg; else if (op == 3) { const float lb = lbv[bj][n][e]; r = __logf(lb + (1.f - lb) * sg); }
                        v[e] = r; }
                }
                ss += (v[0] * v[0] + v[1] * v[1]) + (v[2] * v[2] + v[3] * v[3]);
                *(u32x2*)(rp + bj * HALF + n * 16) = pk4(v); }
            if (ssq >= 0) { ss += __shfl_xor(ss, 16); ss += __shfl_xor(ss, 32); if (fq == 0) SSQ[((size_t)ssq * S + row) * 8 + (pn & 1) * 4 + wc] = ss; }
        }
    }
};

struct EpiQ {
    bf16_t* QB; const float *SSQ, *COS, *SIN;
    __device__ __forceinline__ void operator()(EPI_ARGS) const {
        const int row0 = u.pm * BM + wr * 64 + fr;
#pragma unroll
        EPI_ROWS { const int row = row0 + ai * HALF + m * 16; const f32x4 sa = *(const f32x4*)(SSQ + (size_t)row * 8), sb2 = *(const f32x4*)(SSQ + (size_t)row * 8 + 4); const float rstd = rsqrtf((((sa[0] + sa[1]) + (sa[2] + sa[3])) + ((sb2[0] + sb2[1]) + (sb2[2] + sb2[3]))) * (1.f / 512.f) + RMS_EPS);
#pragma unroll
            for (int bj = 0; bj < 2; ++bj) { const int gg = 8 * u.pn + 4 * bj + wc, part = gg % 6;
                f32x4 x1 = acc[ai][bj][m][0] * rstd, x2 = acc[ai][bj][m][1] * rstd;
                if (part >= 4) { const int i0 = (part - 4) * 16 + 4 * fq;
                    const f32x4 cs = *(const f32x4*)(COS + (size_t)row * 32 + i0), sn = *(const f32x4*)(SIN + (size_t)row * 32 + i0);
                    const f32x4 o1 = x1 * cs - x2 * sn, o2 = x2 * cs + x1 * sn; x1 = o1; x2 = o2; }
                bf16_t* rp = QB + (size_t)row * 1536 + 32 * gg + 4 * fq;
                *(u32x2*)(rp) = pk4(x1); *(u32x2*)(rp + 16) = pk4(x2); } }
    }
};
struct EpiKV {
    bf16_t *KB, *VB; const float* SSQ;
    __device__ __forceinline__ void operator()(EPI_ARGS) const {
        const int row0 = u.pm * BM + wr * 64 + fr; const int c = u.pn * 128 + wc * 32 + 4 * fq;
#pragma unroll
        EPI_ROWS { const int row = row0 + ai * HALF + m * 16; const f32x4 sa = *(const f32x4*)(SSQ + (size_t)row * 8), sb2 = *(const f32x4*)(SSQ + (size_t)row * 8 + 4); const float rstd = rsqrtf((((sa[0] + sa[1]) + (sa[2] + sa[3])) + ((sb2[0] + sb2[1]) + (sb2[2] + sb2[3]))) * (1.f / 512.f) + RMS_EPS);
#pragma unroll
            for (int n = 0; n < 2; ++n) { *(u32x2*)(KB + (size_t)row * 1024 + c + 16 * n) = pk4(acc[ai][0][m][n] * rstd); *(u32x2*)(VB + (size_t)row * 1024 + c + 16 * n) = pk4(acc[ai][1][m][n] * rstd); } }
    }
};
struct EpiMerge {
    const bf16_t* GS; float* MG; bf16_t* MGB;
    __device__ __forceinline__ void operator()(EPI_ARGS) const {
        const int row0 = u.pm * BM + wr * 64 + fr, col0 = u.pn * BM + wc * 32 + 4 * fq; const int z = u.z, gz = (3 - z) % 3;
#pragma unroll
        EPI_ROWS { const size_t row = (size_t)(row0 + ai * HALF + m * 16);
#pragma unroll
            EPI_COLS { const int col = col0 + bj * HALF + n * 16;
                const f32x4 g = unpk4(*(const u32x2*)(GS + row * 6144 + gz * 2048 + col));
                f32x4 v = g * acc[ai][bj][m][n];
                if (z > 0) v += *(const f32x4*)(MG + row * DM + col);
                if (z < 2) *(f32x4*)(MG + row * DM + col) = v; else *(u32x2*)(MGB + row * DM + col) = pk4(v); } }
    }
};
struct EpiWo {
    const float *X, *STATS, *G, *Bv; float* R1;
    __device__ __forceinline__ void operator()(EPI_ARGS) const {
        const int row0 = u.pm * BM + wr * 64 + fr, col0 = u.pn * BM + wc * 32 + 4 * fq;
        f32x4 gv[2][2], bv[2][2];
#pragma unroll
        EPI_COLS { gv[bj][n] = *(const f32x4*)(G + col0 + bj * HALF + n * 16); bv[bj][n] = *(const f32x4*)(Bv + col0 + bj * HALF + n * 16); }
#pragma unroll
        EPI_ROWS { const size_t row = (size_t)(row0 + ai * HALF + m * 16); const float mean = STATS[2 * row], rstd = STATS[2 * row + 1];
#pragma unroll
            EPI_COLS { const int col = col0 + bj * HALF + n * 16; const f32x4 x = *(const f32x4*)(X + row * DM + col);
                const f32x4 h = (x - mean) * rstd * gv[bj][n] + bv[bj][n];
                *(f32x4*)(R1 + row * DM + col) = h * ALPHA + acc[ai][bj][m][n]; } }
    }
};
struct EpiGU {
    bf16_t* ACT;
    __device__ __forceinline__ void operator()(EPI_ARGS) const {
        const int row0 = u.pm * BM + wr * 64 + fr;
#pragma unroll
        EPI_ROWS { const size_t row = (size_t)(row0 + ai * HALF + m * 16);
#pragma unroll
            for (int bj = 0; bj < 2; ++bj) { const int grp = 8 * u.pn + 4 * bj + wc; const f32x4 g = acc[ai][bj][m][0], up = acc[ai][bj][m][1]; f32x4 o;
#pragma unroll
                for (int e = 0; e < 4; ++e) o[e] = g[e] * sigmoidf_(g[e]) * up[e];
                *(u32x2*)(ACT + row * LDACT + 16 * grp + 4 * fq) = pk4(o); } }
    }
};
struct EpiDown {
    const float* H1; float* OUT;
    __device__ __forceinline__ void operator()(EPI_ARGS) const {
        const int row0 = u.pm * BM + wr * 64 + fr, col0 = u.pn * BM + wc * 32 + 4 * fq;
#pragma unroll
        EPI_ROWS { const size_t row = (size_t)(row0 + ai * HALF + m * 16);
#pragma unroll
            EPI_COLS { const int col = col0 + bj * HALF + n * 16; *(f32x4*)(OUT + row * DM + col) = *(const f32x4*)(H1 + row * DM + col) * ALPHA + acc[ai][bj][m][n]; } }
    }
};
}

namespace mla {
constexpr int NW = 8, QBLK = 32, KVBLK = 64;
constexpr float SCALE = 0.07216878364870322f;
constexpr float THR = 8.f;
constexpr int LDQ = 1536, LDKN = 1024, LDKR = 64, LDV = 1024, LDO = 1024;
constexpr int SHM_V = 64 * 128 * 2, SHM_K = 64 * 192 * 2;
#define KSWZ(row, colB) ((row) * 384 + ((colB) ^ (((row) & 7) << 4)))
#define SBAR() __builtin_amdgcn_sched_barrier(0)
__device__ __forceinline__ int crow(int r, int hi) { return (r & 3) + 8 * (r >> 2) + 4 * hi; }
__device__ __forceinline__ unsigned cvtpk(float lo, float hi) { unsigned r; asm volatile("v_cvt_pk_bf16_f32 %0, %1, %2" : "=v"(r) : "v"(lo), "v"(hi)); return r; }

__device__ __forceinline__ void partialSM(f32x16& p0, f32x16& p1, float& m_reg, float& mn, float& alpha) {
    constexpr float C = SCALE * 1.4426950408889634f;
    float pmax = p0[0];
#pragma unroll
    for (int r = 1; r < 16; ++r) pmax = fmaxf(pmax, p0[r]);
#pragma unroll
    for (int r = 0; r < 16; ++r) pmax = fmaxf(pmax, p1[r]);
    { auto rr = __builtin_amdgcn_permlane32_swap(__float_as_uint(pmax), __float_as_uint(pmax), false, false);
      pmax = fmaxf(__uint_as_float(rr[0]), __uint_as_float(rr[1])); }
    if (__builtin_expect(__all(pmax - m_reg <= THR / SCALE), 1)) { mn = m_reg; alpha = 1.f; }
    else { mn = fmaxf(m_reg, pmax); alpha = __builtin_amdgcn_exp2f((m_reg - mn) * C); m_reg = mn; }
    float mnC = -mn * C;
#pragma unroll
    for (int r = 0; r < 16; ++r) p0[r] = fmaf(p0[r], C, mnC);
#pragma unroll
    for (int r = 0; r < 16; ++r) p1[r] = fmaf(p1[r], C, mnC);
#pragma unroll
    for (int r = 0; r < 16; ++r) p0[r] = __builtin_amdgcn_exp2f(p0[r]);
}
__device__ __forceinline__ void finishSM(f32x16& p0, f32x16& p1, float alpha, float& l_reg, bf16x8& pa0, bf16x8& pa1, bf16x8& pa2, bf16x8& pa3) {
#pragma unroll
    for (int r = 0; r < 16; ++r) p1[r] = __builtin_amdgcn_exp2f(p1[r]);
    float ps = 0;
#pragma unroll
    for (int r = 0; r < 16; ++r) ps += p0[r];
#pragma unroll
    for (int r = 0; r < 16; ++r) ps += p1[r];
    { auto rr = __builtin_amdgcn_permlane32_swap(__float_as_uint(ps), __float_as_uint(ps), false, false);
      ps = __uint_as_float(rr[0]) + __uint_as_float(rr[1]); }
    l_reg = l_reg * alpha + ps;
#define PK4(P, BASE, OUT) do { unsigned a0 = cvtpk(P[BASE + 0], P[BASE + 1]), a1 = cvtpk(P[BASE + 2], P[BASE + 3]);   \
    unsigned b0 = cvtpk(P[BASE + 4], P[BASE + 5]), b1 = cvtpk(P[BASE + 6], P[BASE + 7]);                              \
    auto r0 = __builtin_amdgcn_permlane32_swap(a0, b0, false, false); auto r1 = __builtin_amdgcn_permlane32_swap(a1, b1, false, false); \
    u32x4 w = {r0[0], r1[0], r0[1], r1[1]}; OUT = *reinterpret_cast<bf16x8*>(&w); } while (0)
    PK4(p0, 0, pa0); PK4(p0, 8, pa1); PK4(p1, 0, pa2); PK4(p1, 8, pa3);
#undef PK4
}
__device__ __forceinline__ void qkt(f32x16& p0, f32x16& p1, const char* Ks, const bf16x8* qr, int r32, int hi) {
    p0 = f32x16{}; p1 = f32x16{};
#pragma unroll
    for (int d0 = 0; d0 < 12; ++d0) { int cb = (d0 * 16 + hi * 8) * 2;
        bf16x8 b0 = *reinterpret_cast<const bf16x8*>(Ks + KSWZ(r32, cb));
        bf16x8 b1 = *reinterpret_cast<const bf16x8*>(Ks + KSWZ(32 + r32, cb));
        p0 = __builtin_amdgcn_mfma_f32_32x32x16_bf16(b0, qr[d0], p0, 0, 0, 0);
        p1 = __builtin_amdgcn_mfma_f32_32x32x16_bf16(b1, qr[d0], p1, 0, 0, 0); }
}
__device__ __forceinline__ int v_st(int k, int c) { const int kk = (k & ~0xC) | ((k & 4) << 1) | ((k & 8) >> 1); return ((kk >> 3) * 4 + (c >> 5)) * 512 + ((kk & 7) * 32 + (c & 31)) * 2; }
__device__ __forceinline__ int v_rd_base(int lane) { return ((lane & 3) << 3) | (((lane >> 2) & 3) << 6) | (((lane >> 4) & 1) << 5) | (((lane >> 5) & 1) << 8); }
constexpr int v_rd_off(int d0, int ks, int half) { return d0 * 512 + ks * 4096 + half * 2048; }
template <int OFF> __device__ __forceinline__ s16x4 tr_read(int vb) {
    s16x4 r; asm volatile("ds_read_b64_tr_b16 %0, %1 offset:%2" : "=&v"(r) : "v"(vb), "i"(OFF) : "memory"); return r;
}
template <int D0> __device__ __forceinline__ void pv_one(f32x16& od, int vb, bf16x8 pa0, bf16x8 pa1, bf16x8 pa2, bf16x8 pa3) {
    const s16x4 l0 = tr_read<v_rd_off(D0, 0, 0)>(vb), h0 = tr_read<v_rd_off(D0, 0, 1)>(vb), l1 = tr_read<v_rd_off(D0, 1, 0)>(vb), h1 = tr_read<v_rd_off(D0, 1, 1)>(vb);
    const s16x4 l2 = tr_read<v_rd_off(D0, 2, 0)>(vb), h2 = tr_read<v_rd_off(D0, 2, 1)>(vb), l3 = tr_read<v_rd_off(D0, 3, 0)>(vb), h3 = tr_read<v_rd_off(D0, 3, 1)>(vb);
    asm volatile("s_waitcnt lgkmcnt(0)" ::: "memory"); SBAR();
#define PK(L, H) (bf16x8){L[0], L[1], L[2], L[3], H[0], H[1], H[2], H[3]}
    od = __builtin_amdgcn_mfma_f32_32x32x16_bf16(pa0, PK(l0, h0), od, 0, 0, 0);
    od = __builtin_amdgcn_mfma_f32_32x32x16_bf16(pa1, PK(l1, h1), od, 0, 0, 0);
    od = __builtin_amdgcn_mfma_f32_32x32x16_bf16(pa2, PK(l2, h2), od, 0, 0, 0);
    od = __builtin_amdgcn_mfma_f32_32x32x16_bf16(pa3, PK(l3, h3), od, 0, 0, 0);
#undef PK
}
__device__ __forceinline__ void pv_d0(f32x16* o, int vb, bf16x8 pa0, bf16x8 pa1, bf16x8 pa2, bf16x8 pa3) {
    pv_one<0>(o[0], vb, pa0, pa1, pa2, pa3); pv_one<1>(o[1], vb, pa0, pa1, pa2, pa3); pv_one<2>(o[2], vb, pa0, pa1, pa2, pa3); pv_one<3>(o[3], vb, pa0, pa1, pa2, pa3);
}

__device__ __forceinline__ void attn_unit(const bf16_t* __restrict__ Qb, const bf16_t* __restrict__ Kn, const bf16_t* __restrict__ Kr, const bf16_t* __restrict__ Vh,
                                          bf16_t* __restrict__ Ob, int seq, char* lds) {
    const int tid = threadIdx.x, wid = tid >> 6, lane = tid & 63, r32 = lane & 31, hi = lane >> 5;
    char* V_lds = lds; char* K_lds = lds + 2 * SHM_V;
    float* ws = (float*)(lds + 2 * SHM_V + 2 * SHM_K) + wid * 64; float* li_l = ws; float* al_l = ws + 32;
    float m_reg = -1e30f, l_reg = 0; f32x16 o[4] = {}; bf16x8 qr[12];
    const bf16_t* Qw = Qb + (long)(wid * QBLK + r32) * LDQ + hi * 8;
#pragma unroll
    for (int d0 = 0; d0 < 12; ++d0) qr[d0] = *reinterpret_cast<const bf16x8*>(Qw + d0 * 16);
    const int sr = tid >> 4, sc = (tid & 15) * 8, vst0 = v_st(sr, sc), vst1 = v_st(32 + sr, sc);
    const int vb0 = (int)(uintptr_t)V_lds + v_rd_base(lane);
    const bf16_t* kp[3]; int kstr[3], kst[3];
#pragma unroll
    for (int i = 0; i < 3; ++i) { const int q = tid + 512 * i, row = q / 24, cc = q % 24;
        kp[i] = (cc < 16) ? (Kn + (long)row * LDKN + cc * 8) : (Kr + (long)row * LDKR + (cc - 16) * 8); kstr[i] = (cc < 16) ? LDKN : LDKR; kst[i] = KSWZ(row, cc * 16); }
    bf16x8 vs0, vs1, ks0, ks1, ks2;
#define SLOAD(k0) do { vs0 = *reinterpret_cast<const bf16x8*>(&Vh[(long)((k0) + sr) * LDV + sc]); vs1 = *reinterpret_cast<const bf16x8*>(&Vh[(long)((k0) + 32 + sr) * LDV + sc]); \
    ks0 = *reinterpret_cast<const bf16x8*>(kp[0] + (long)(k0) * kstr[0]); ks1 = *reinterpret_cast<const bf16x8*>(kp[1] + (long)(k0) * kstr[1]); ks2 = *reinterpret_cast<const bf16x8*>(kp[2] + (long)(k0) * kstr[2]); } while (0)
#define SWRITE(b) do { *(bf16x8*)(V_lds + (b) * SHM_V + vst0) = vs0; *(bf16x8*)(V_lds + (b) * SHM_V + vst1) = vs1; \
    *(bf16x8*)(K_lds + (b) * SHM_K + kst[0]) = ks0; *(bf16x8*)(K_lds + (b) * SHM_K + kst[1]) = ks1; *(bf16x8*)(K_lds + (b) * SHM_K + kst[2]) = ks2; } while (0)
#define SWAIT() asm volatile("s_waitcnt vmcnt(0)" ::: "memory")
#define RESC(a) do { if (__any((a) < 1.f)) { if (hi == 0) al_l[r32] = (a); asm volatile("s_waitcnt lgkmcnt(0)" ::: "memory"); \
    _Pragma("unroll") for (int d = 0; d < 4; ++d) _Pragma("unroll") for (int r = 0; r < 16; ++r) o[d][r] *= al_l[crow(r, hi)]; } } while (0)
    f32x16 pA0, pA1; float mnA, alA; bf16x8 pa0, pa1, pa2, pa3; const int NT = seq / KVBLK;
    SLOAD(0); SWAIT(); SWRITE(0); __syncthreads();
#pragma unroll 1
    for (int j = 0; j < NT; ++j) {
        const int buf = j & 1;
        if (j + 1 < NT) SLOAD((j + 1) * KVBLK);
        SBAR(); qkt(pA0, pA1, K_lds + buf * SHM_K, qr, r32, hi);
        partialSM(pA0, pA1, m_reg, mnA, alA);
        RESC(alA);
        finishSM(pA0, pA1, alA, l_reg, pa0, pa1, pa2, pa3); SBAR();
        pv_d0(o, vb0 + buf * (int)SHM_V, pa0, pa1, pa2, pa3);
        if (j + 1 < NT) { SWAIT(); SWRITE(buf ^ 1); }
        __syncthreads();
    }
    if (hi == 0) li_l[r32] = l_reg; asm volatile("s_waitcnt lgkmcnt(0)" ::: "memory");
    float rli[16];
#pragma unroll
    for (int r = 0; r < 16; ++r) rli[r] = __builtin_amdgcn_rcpf(li_l[crow(r, hi)]);
    bf16_t* Ow = Ob + (long)(wid * QBLK) * LDO;
#pragma unroll
    for (int r = 0; r < 16; ++r) { int orow = crow(r, hi);
#pragma unroll
        for (int d0 = 0; d0 < 4; ++d0) Ow[(long)orow * LDO + d0 * 32 + r32] = (bf16_t)f2bf(o[d0][r] * rli[r]); }
    __syncthreads();
#undef SLOAD
#undef SWRITE
#undef SWAIT
#undef RESC
}
#undef SBAR
}

#define XB_TMO      128
#define XB_XCNT(j)  (256  + 64 * (j))
#define XB_XSUB(j)  (1280 + 64 * (j))
#define XB_XGEN(j)  (2304 + 64 * (j))
#define XB_TOP      3328
#define XB_TOPGEN   3392
#define XCD_BAR_WORDS 3456
#define XB_SPIN_CAP (1u << 22)
__device__ __forceinline__ unsigned xb_ld(unsigned* p)              { return __hip_atomic_load(p, __ATOMIC_RELAXED, __HIP_MEMORY_SCOPE_AGENT); }
__device__ __forceinline__ unsigned xb_add(unsigned* p, unsigned v) { return __hip_atomic_fetch_add(p, v, __ATOMIC_RELAXED, __HIP_MEMORY_SCOPE_AGENT); }
__device__ __forceinline__ unsigned xb_xcc_id() { return (unsigned)__builtin_amdgcn_s_getreg((3 << 11) | 20) & 0xFu; }
#define XB_SPIN(cond, bar) do { unsigned _sp = 0; while (cond) { __builtin_amdgcn_s_sleep(1); \
    if ((++_sp & 255u) == 0u) { if (xb_ld(&(bar)[XB_TMO])) break; if (_sp > XB_SPIN_CAP) { atomicAdd(&(bar)[XB_TMO], 1u); break; } } } } while (0)
struct XcdBarrier { unsigned* bar; unsigned x; volatile LAS unsigned* st; };
__device__ __forceinline__ XcdBarrier xcd_barrier_post(unsigned* bar, volatile LAS unsigned* st) {
    XcdBarrier b; b.bar = bar; b.x = xb_xcc_id(); b.st = st;
    if (threadIdx.x == 0) (void)xb_add(&bar[XB_XCNT(b.x)], 1u);
    return b;
}
__device__ __forceinline__ void xcd_barrier_complete(unsigned* bar, unsigned x, unsigned& nloc, unsigned& nx) {
    const unsigned G = gridDim.x * gridDim.y * gridDim.z;
    unsigned sum, cnt, mine, sp = 0u;
    for (;;) {
        sum = 0u; cnt = 0u; mine = 0u;
#pragma unroll
        for (unsigned j = 0; j < 16; ++j) { const unsigned c = xb_ld(&bar[XB_XCNT(j)]); sum += c; cnt += (c > 0u) ? 1u : 0u; mine = (j == x) ? c : mine; }
        if (sum == G) break;
        __builtin_amdgcn_s_sleep(1);
        if ((++sp & 255u) == 0u) { if (xb_ld(&bar[XB_TMO])) break; if (sp > XB_SPIN_CAP) { atomicAdd(&bar[XB_TMO], 1u); break; } }
    }
    nloc = mine > 0u ? mine : 1u; nx = cnt > 0u ? cnt : 1u;
}
__device__ __forceinline__ void xcd_barrier(const XcdBarrier& b) {
    asm volatile("s_waitcnt vmcnt(0)" ::: "memory");
    __syncthreads();
    if (threadIdx.x == 0) {
        unsigned* bar = b.bar;
        __builtin_amdgcn_s_waitcnt(0);
        unsigned nloc = b.st[0], nx = b.st[1];
        if (nloc == 0u) { xcd_barrier_complete(bar, b.x, nloc, nx); b.st[0] = nloc; b.st[1] = nx; }
        const unsigned old = xb_add(&bar[XB_XSUB(b.x)], 1u);
        const unsigned gen = old / nloc;
        if (old + 1u == (gen + 1u) * nloc) {
            __builtin_amdgcn_fence(__ATOMIC_RELEASE, "agent");
            asm volatile("s_waitcnt vmcnt(0)" ::: "memory");
            const unsigned og = xb_add(&bar[XB_TOP], 1u);
            const unsigned tg = og / nx;
            if (og + 1u == (tg + 1u) * nx) xb_add(&bar[XB_TOPGEN], 1u);
            else XB_SPIN(xb_ld(&bar[XB_TOPGEN]) == tg, bar);
            __builtin_amdgcn_fence(__ATOMIC_ACQUIRE, "agent");
            xb_add(&bar[XB_XGEN(b.x)], 1u);
            asm volatile("s_waitcnt vmcnt(0)" ::: "memory");
        } else {
            XB_SPIN(xb_ld(&bar[XB_XGEN(b.x)]) == gen, bar);
            __builtin_amdgcn_fence(__ATOMIC_ACQUIRE, "agent");
            asm volatile("s_waitcnt vmcnt(0)" ::: "memory");
        }
    }
    __syncthreads();
}

struct Args { const float* in[22]; float* out; unsigned char* ws; int ph_lo, ph_hi; };

__device__ __forceinline__ const float* tr_src(int mode, const float* Wa, const float* Wb, int nd, int run) {
    if (mode == 0) return Wa + nd + 16 * run;
    if (mode == 1) { if (nd < 6144) return Wa + nd + 16 * run; if (nd < 13312) return Wa + nd + 64 + 16 * run; if (nd < 13376) return Wa + 6144 + 16 * ((nd - 13312) >> 5) + 32 * run; return nullptr; }
    if (mode == 2) { const int grp = nd >> 5, part = grp % 6, h = grp / 6; if (part < 4) return Wa + nd + 16 * run; return Wa + 192 * h + 128 + 16 * (part - 4) + 32 * run; }
    return (run ? Wb : Wa) + 16 * (nd >> 5);
}
__device__ __forceinline__ void tr_item2(int mode, const float* Wa, const float* Wb, int ldw, int k0, int n0, bf16_t* WT, int ldt, const float* ksc, float* scr, int lane) {
    const int j = lane & 15, kq = lane >> 4;
    const float* src = tr_src(mode, Wa, Wb, n0 + 32 * (j >> 3), (j >> 2) & 1);
    f32x4 v[16];
#pragma unroll
    for (int i = 0; i < 16; ++i) { const int kk = kq + 4 * i; v[i] = src ? *(const f32x4*)(src + (size_t)(k0 + kk) * ldw + 4 * (j & 3)) : (f32x4){0.f, 0.f, 0.f, 0.f}; }
#pragma unroll
    for (int i = 0; i < 16; ++i) { const int kk = kq + 4 * i; f32x4 w = v[i]; if (ksc) w = w * ksc[k0 + kk]; float* d = scr + kk * 65 + 4 * j; d[0] = w[0]; d[1] = w[1]; d[2] = w[2]; d[3] = w[3]; }
    LDS_WAIT();
    const int c = lane & 7;
#pragma unroll
    for (int t = 0; t < 8; ++t) { const int n = (lane >> 3) + 8 * t; const float* sp = scr + (8 * c) * 65 + n;
        u32x4 o; o.x = pk2(sp[0 * 65], sp[1 * 65]); o.y = pk2(sp[2 * 65], sp[3 * 65]); o.z = pk2(sp[4 * 65], sp[5 * 65]); o.w = pk2(sp[6 * 65], sp[7 * 65]);
        *(u32x4*)(WT + (size_t)(n0 + n) * ldt + k0 + 8 * c) = o; }
    LDS_WAIT();
}
__device__ __forceinline__ void tr_mat(int mode, const float* Wa, const float* Wb, int K, int ldw, int N, bf16_t* WT, int ldt, const float* ksc, float* scr, int lane, int gw, int NGW) {
    const int nkb = K / 64, nit = nkb * (N / 64);
    for (int it = gw; it < nit; it += NGW) { const int nb = it / nkb, kb = it % nkb; tr_item2(mode, Wa, Wb, ldw, 64 * kb, 64 * nb, WT, ldt, ksc, scr, lane); }
}
__device__ __forceinline__ void ln_row(const float* xrow, const float* g, const float* b, float* of, bf16_t* ob, float* stats, int lane) {
    const f32x4* xr = (const f32x4*)xrow + lane;
    f32x4 v[8]; float s = 0.f;
#pragma unroll
    for (int j = 0; j < 8; ++j) { v[j] = xr[64 * j]; s += (v[j][0] + v[j][1]) + (v[j][2] + v[j][3]); }
    const float mean = wave_sum(s) * (1.f / DM); float s2 = 0.f;
#pragma unroll
    for (int j = 0; j < 8; ++j) { v[j] = v[j] - mean; s2 += (v[j][0] * v[j][0] + v[j][1] * v[j][1]) + (v[j][2] * v[j][2] + v[j][3] * v[j][3]); }
    const float rstd = rsqrtf(wave_sum(s2) * (1.f / DM) + LN_EPS);
    if (stats && lane == 0) { stats[0] = mean; stats[1] = rstd; }
#pragma unroll
    for (int j = 0; j < 8; ++j) { const f32x4 gv = ((const f32x4*)g)[64 * j + lane], bv = ((const f32x4*)b)[64 * j + lane]; const f32x4 y = v[j] * rstd * gv + bv;
        if (of) ((f32x4*)of)[64 * j + lane] = y;
        if (ob) ((u32x2*)ob)[64 * j + lane] = pk4(y); }
}

__global__ void __launch_bounds__(512) mega(Args a) {
    extern __shared__ __attribute__((aligned(16))) unsigned char lds[];
    cg::grid_group grid = cg::this_grid();
    const int tid = threadIdx.x, lane = tid & 63, wave = __builtin_amdgcn_readfirstlane(tid >> 6);
    const int G = gridDim.x, bid = blockIdx.x;
    const int gw = bid * 8 + wave, NGW = G * 8;
    unsigned char* ws = a.ws;
    LAS unsigned char* ldsl = (LAS unsigned char*)lds;
    const float* x = a.in[0]; const float* memp = a.in[1]; const int* positions = (const int*)a.in[2];
    const float *ln_emb_g = a.in[3], *ln_emb_b = a.in[4], *lb_logits = a.in[5], *w_in = a.in[6], *hg_norm_g = a.in[7], *g_cq = a.in[8], *g_ckv = a.in[9];
    const float *w_uq = a.in[10], *w_ukv = a.in[11], *w_kvm = a.in[12], *w_branch = a.in[13], *w_o = a.in[14], *ln1_g = a.in[15], *ln1_b = a.in[16];
    const float *w_gate = a.in[17], *w_up = a.in[18], *w_down = a.in[19], *ln2_g = a.in[20], *ln2_b = a.in[21];
    float* out = a.out;
    volatile LAS unsigned* xst = (volatile LAS unsigned*)(ldsl + (LDS_BYTES - 64));
    if (tid < 2) xst[tid] = 0u;
    __syncthreads();
    XcdBarrier xbar = xcd_barrier_post((unsigned*)ws, xst);
    if (a.ph_hi > 1000) grid.sync();
#define WSP(T, off) ((T*)(ws + (off)))
    float* SSQ = WSP(float, WS_SSQ); float* STATS = WSP(float, WS_STATS); float* LB = WSP(float, WS_LB);
    float* COS = WSP(float, WS_COS); float* SIN = WSP(float, WS_SIN); float* DVEC = WSP(float, WS_DVEC);
    bf16_t *WIN_T = WSP(bf16_t, WS_WIN_T), *H0B = WSP(bf16_t, WS_H0B), *WUQ_T = WSP(bf16_t, WS_WUQ_T), *WUKV_T = WSP(bf16_t, WS_WUKV_T), *WKV_T = WSP(bf16_t, WS_WKV_T), *MEMB = WSP(bf16_t, WS_MEMB);
    bf16_t *KVM = WSP(bf16_t, WS_KVM), *VMT = WSP(bf16_t, WS_VMT), *KR = WSP(bf16_t, WS_KR);
    bf16_t *QH = WSP(bf16_t, WS_QH), *VH = WSP(bf16_t, WS_VH), *GF = WSP(bf16_t, WS_GF), *GH = WSP(bf16_t, WS_GH), *CQ = WSP(bf16_t, WS_CQ), *CKV = WSP(bf16_t, WS_CKV), *QM = WSP(bf16_t, WS_QM), *GS = WSP(bf16_t, WS_GS);
    bf16_t *HS = WSP(bf16_t, WS_HS), *YA = WSP(bf16_t, WS_YA), *WBR_T = WSP(bf16_t, WS_WBR_T), *WO_T = WSP(bf16_t, WS_WO_T);
    bf16_t *KB = WSP(bf16_t, WS_KB), *VB = WSP(bf16_t, WS_VB), *QB = WSP(bf16_t, WS_QB), *SC = WSP(bf16_t, WS_SC), *PM = WSP(bf16_t, WS_PM), *YH = WSP(bf16_t, WS_YH), *YM = WSP(bf16_t, WS_YM);
    float* MERGED = WSP(float, WS_MERGED); bf16_t* MERGEDB = WSP(bf16_t, WS_MERGEDB); float* R1 = WSP(float, WS_R1); bf16_t* H1B = WSP(bf16_t, WS_H1B);
    bf16_t *WGU_T = WSP(bf16_t, WS_WGU_T), *WD_T = WSP(bf16_t, WS_WD_T), *ACT = WSP(bf16_t, WS_ACT);

#ifndef PHMASK
#define PHMASK 0x7ff
#endif
#define IN(k) (((PHMASK >> (k)) & 1) && a.ph_lo <= (k) && (k) < a.ph_hi)
#define SEAM(k) do { if (IN(k) && IN((k) + 1)) xcd_barrier(xbar); } while (0)

    if (IN(0)) {
        float* scr = (float*)lds + wave * (64 * 65);
        tr_mat(1, w_in, w_in, DM, 13376, NINP, WIN_T, DM, nullptr, scr, lane, gw, NGW);
        tr_mat(2, w_uq, w_uq, 512, 1536, 1536, WUQ_T, 512, g_cq, scr, lane, gw, NGW);
        tr_mat(0, w_ukv, w_ukv, 512, 2048, 2048, WUKV_T, 512, g_ckv, scr, lane, gw, NGW);
        tr_mat(0, w_kvm, w_kvm, 2048, 2048, 2048, WKV_T, DM, nullptr, scr, lane, gw, NGW);
        for (int z = 0; z < 3; ++z) tr_mat(0, w_branch + (size_t)((3 - z) % 3) * 1024 * 2048, nullptr, 1024, 2048, 2048, WBR_T + (size_t)z * 2048 * 1024, 1024, nullptr, scr, lane, gw, NGW);
        tr_mat(0, w_o, w_o, 2048, 2048, 2048, WO_T, DM, nullptr, scr, lane, gw, NGW);
        for (int m = gw; m < S; m += NGW) ln_row(x + (size_t)m * DM, ln_emb_g, ln_emb_b, nullptr, H0B + (size_t)m * DM, STATS + 2 * m, lane);
        const int gt = bid * 512 + tid, NGT = G * 512;
        for (int i = gt; i < S * 32; i += NGT) { const int s = i >> 5, f = i & 31;
            const double invf = exp(-(double)f * (9.210340371976184 / 32.0));
            const double t = (double)positions[s] * invf * 0.15915494309189535; const float fr = (float)(t - rint(t));
            COS[i] = __builtin_amdgcn_cosf(fr); SIN[i] = __builtin_amdgcn_sinf(fr); }
        for (int i = gt; i < 2048; i += NGT) { const int z = i >> 10, w = i & 1023; const float l0 = lb_logits[(z * 2 + 0) * 1024 + w], l1 = lb_logits[(z * 2 + 1) * 1024 + w]; LB[i] = 1.f / (1.f + __expf(l1 - l0)); }
        for (int i = gt; i < NMEM * DM / 4; i += NGT) ((u32x2*)MEMB)[i] = pk4(((const f32x4*)memp)[i]);
        __syncthreads();
    }
    SEAM(0);
    if (IN(1)) {
        {   pg8::Sched Sc; Sc.init(S, NINP, 1, G, bid); Sc.a_z = 0; Sc.A0 = (const char*)H0B; Sc.B = (const char*)WIN_T; Sc.a_pm = 256L * DM * 2; Sc.a_pn = 0; Sc.b_pn = 256L * DM * 2; Sc.b_z = 0;
            pg8::EpiP1 E{QH, VH, GF, GH, CQ, CKV, QM, GS, KR, SSQ, LB, COS, SIN};
            pg8::gemm_phase<pg8::EpiP1, true>(ldsl, DM, DM, DM, Sc, E); }
        {
            pg8::Sched Sc; Sc.init(NMEM, 1024, 1, G, bid); Sc.a_z = 0; Sc.A0 = (const char*)MEMB; Sc.B = (const char*)WKV_T; Sc.a_pm = 0; Sc.a_pn = 0; Sc.b_pn = 256L * DM * 2; Sc.b_z = 0;
            pg8::EpiStore E{KVM, 1024, 1.f};
            pg8::gemm_phase<pg8::EpiStore, true>(ldsl, DM, DM, DM, Sc, E); }
        {
            pg8::Sched Sc; Sc.init(1024, NMEM, 1, G, bid); Sc.a_z = 0; Sc.A0 = (const char*)(WKV_T + (size_t)1024 * DM); Sc.B = (const char*)MEMB; Sc.a_pm = 256L * DM * 2; Sc.a_pn = 0; Sc.b_pn = 0; Sc.b_z = 0;
            pg8::EpiStore E{VMT, 256, 1.f};
            pg8::gemm_phase<pg8::EpiStore, true>(ldsl, DM, DM, DM, Sc, E); }
    }
    SEAM(1);
    if (IN(2)) {
#ifndef DBG_SKIPG2
        {   pg8::Sched Sc; Sc.init(S, 1536, 1, G, bid); Sc.a_z = 0; Sc.A0 = (const char*)CQ; Sc.B = (const char*)WUQ_T; Sc.a_pm = 256L * 512 * 2; Sc.a_pn = 0; Sc.b_pn = 256L * 512 * 2; Sc.b_z = 0;
            pg8::EpiQ E{QB, SSQ, COS, SIN};
            pg8::gemm_phase<pg8::EpiQ, true>(ldsl, 512, 512, 512, Sc, E); }
        {   pg8::Sched Sc; Sc.init(S, 2048, 1, G, bid); Sc.a_z = 0; Sc.A0 = (const char*)CKV; Sc.B = (const char*)WUKV_T; Sc.a_pm = 256L * 512 * 2; Sc.a_pn = 0; Sc.b_pn = 256L * 512 * 2; Sc.b_z = 0;
            pg8::EpiKV E{KB, VB, SSQ + (size_t)S * 8};
            pg8::gemm_phase<pg8::EpiKV, true>(ldsl, 512, 512, 512, Sc, E); }
        {
            pg8::Sched Sc; Sc.init(S, 1024, 1, G, bid); Sc.a_z = 0; Sc.A0 = (const char*)QM; Sc.B = (const char*)KVM; Sc.a_pm = 256L * 1024 * 2; Sc.a_pn = 256 * 2; Sc.b_pn = 256 * 2; Sc.b_z = 0;
            pg8::EpiStore E{SC, 1024, 0.0625f};
            pg8::gemm_phase<pg8::EpiStore, true>(ldsl, 1024, 1024, 256, Sc, E); }
#endif
#ifdef DBG_COPY
        { const size_t gt2 = (size_t)bid * 512 + tid, NGT2 = (size_t)G * 512;
          for (size_t j = gt2; j < 16777216; j += NGT2) { HS[j] = GF[j]; HS[16777216 + j] = VH[j & 8388607]; }
          for (size_t j = gt2; j < 262144; j += NGT2) DVEC[j] = 1.f; }
#else
        {
            bf16_t* KwT = (bf16_t*)lds;
            bf16_t* VT = (bf16_t*)(lds + 18432);
            float* TOT = (float*)(lds + 36864);
            const int ch = tid & 127, sb = tid >> 7;
            for (int it = bid; it < 2048; it += G) {
                const int z = it >> 10, h = (it >> 7) & 7, c = it & 127, t0 = 64 * c;
                __syncthreads();
                float gr[16], ar[16]; float acc_a = 0.f;
#pragma unroll
                for (int r = 0; r < 16; ++r) { const int tau = 16 * sb + r, t = z ? (t0 + 63 - tau) : (t0 + tau);
                    const float g = bf2f(GF[(size_t)z * S * 1024 + (size_t)t * 1024 + 128 * h + ch]); acc_a += g; gr[r] = g; ar[r] = acc_a; }
                TOT[sb * 128 + ch] = acc_a;
#pragma unroll
                for (int j = 0; j < 2; ++j) { const int q = tid + 512 * j, tau = q >> 4, vc0 = (q & 15) * 8, t = z ? (t0 + 63 - tau) : (t0 + tau);
                    const bf16x8 v = *(const bf16x8*)(VH + (size_t)t * 1024 + 128 * h + vc0);
#pragma unroll
                    for (int e = 0; e < 8; ++e) VT[(vc0 + e) * 72 + tau] = (bf16_t)v[e]; }
                __syncthreads();
                float later = 0.f;
#pragma unroll
                for (int i2 = 1; i2 < 4; ++i2) if (i2 > sb) later += TOT[i2 * 128 + ch];
                if (sb == 0) DVEC[(size_t)it * 128 + ch] = __expf(acc_a + later);
#pragma unroll
                for (int r = 0; r < 16; ++r) { const float k = 1.f - __expf(gr[r]); KwT[ch * 72 + 16 * sb + r] = (bf16_t)f2bf(k * __expf((acc_a - ar[r]) + later)); }
                __syncthreads();
                f32x4 acc[8];
#pragma unroll
                for (int nb = 0; nb < 8; ++nb) acc[nb] = (f32x4){0.f, 0.f, 0.f, 0.f};
#pragma unroll
                for (int ks = 0; ks < 2; ++ks) { const bf16x8 A = *(const bf16x8*)(KwT + (16 * wave + (lane & 15)) * 72 + 32 * ks + (lane >> 4) * 8);
#pragma unroll
                    for (int nb = 0; nb < 8; ++nb) { const bf16x8 Bv = *(const bf16x8*)(VT + (16 * nb + (lane & 15)) * 72 + 32 * ks + (lane >> 4) * 8);
                        acc[nb] = __builtin_amdgcn_mfma_f32_16x16x32_bf16(A, Bv, acc[nb], 0, 0, 0); } }
                bf16_t* hs = HS + (size_t)it * 16384;
#pragma unroll
                for (int nb = 0; nb < 8; ++nb) *(u32x2*)(hs + (16 * nb + (lane & 15)) * 128 + 16 * wave + (lane >> 4) * 4) = pk4(acc[nb]);
            }
            __syncthreads();
        }
#endif
    }
    SEAM(2);
    if (IN(3)) {
        {
            const int gt = bid * 512 + tid, NGT = G * 512;
            for (int p = gt; p < 16 * 8192; p += NGT) { const int zh = p >> 13, e2 = p & 8191, z = zh >> 3, kch = (2 * e2) & 127;
                float s0 = 0.f, s1 = 0.f;
#pragma unroll 4
                for (int n = 0; n < 128; ++n) { const int c = z ? (127 - n) : n; const size_t it = (size_t)zh * 128 + c;
                    unsigned* pp = (unsigned*)(HS + it * 16384 + 2 * e2); const unsigned uu = *pp; const float d0 = DVEC[it * 128 + kch], d1 = DVEC[it * 128 + kch + 1];
                    *pp = cvt_pk_bf16(s0, s1);
                    s0 = d0 * s0 + __uint_as_float(uu << 16); s1 = d1 * s1 + __uint_as_float(uu & 0xffff0000u); } }
        }
        {
            for (int r = gw; r < S * 4; r += NGW) { const u32x2 w = *(const u32x2*)(SC + (size_t)r * 256 + 4 * lane); f32x4 v = unpk4(w);
                const float mx = wave_max(fmaxf(fmaxf(v[0], v[1]), fmaxf(v[2], v[3])));
#pragma unroll
                for (int e = 0; e < 4; ++e) v[e] = __expf(v[e] - mx);
                const float sm = wave_sum((v[0] + v[1]) + (v[2] + v[3])); const float inv = 1.f / sm;
                *(u32x2*)(PM + (size_t)r * 256 + 4 * lane) = pk4(v * inv); }
        }
        __syncthreads();
        for (int un = bid; un < 256; un += G) { const int h = un & 7, qb = un >> 3;
            mla::attn_unit(QB + (size_t)qb * 256 * 1536 + 192 * h, KB + 128 * h, KR, VB + 128 * h, YA + (size_t)qb * 256 * 1024 + 128 * h, S, (char*)lds); }
    }
    SEAM(3);
    if (IN(4)) {
        {   pg8::Sched Sc; Sc.init(S, 1024, 1, G, bid); Sc.a_z = 0; Sc.A0 = (const char*)PM; Sc.B = (const char*)VMT; Sc.a_pm = 256L * 1024 * 2; Sc.a_pn = 256 * 2; Sc.b_pn = 256L * 256 * 2; Sc.b_z = 0;
            pg8::EpiStore E{YM, 1024, 1.f};
            pg8::gemm_phase<pg8::EpiStore, true>(ldsl, 1024, 256, 256, Sc, E); }
        {
            bf16_t* QT = (bf16_t*)lds;
            bf16_t* KBt = (bf16_t*)(lds + 17408);
            bf16_t* KHT = (bf16_t*)(lds + 34816);
            bf16_t* VT = (bf16_t*)(lds + 53248);
            bf16_t* ST = (bf16_t*)(lds + 71680);
            float* O = (float*)(lds + 106496);
            float* Dd = (float*)(lds + 139264);
            bf16_t* PW = (bf16_t*)(lds + 141312) + wave * 256;
            const int ch = tid & 127, sb = tid >> 7, l15 = lane & 15, l4 = lane >> 4;
            for (int it = bid; it < 1024; it += G) {
                const int h = it >> 7, c = it & 127, t0 = 64 * c;
#pragma unroll 1
                for (int z = 0; z < 2; ++z) {
                    __syncthreads();
                    {   float gr[16], ar[16]; float aa = 0.f;
#pragma unroll
                        for (int r = 0; r < 16; ++r) { const int tau = 16 * sb + r, t = z ? (t0 + 63 - tau) : (t0 + tau);
                            const float g = bf2f(GF[(size_t)z * S * 1024 + (size_t)t * 1024 + 128 * h + ch]); aa += g; gr[r] = g; ar[r] = aa; }
                        Dd[sb * 128 + ch] = __expf(aa);
#pragma unroll
                        for (int r = 0; r < 16; ++r) { const int tau = 16 * sb + r, t = z ? (t0 + 63 - tau) : (t0 + tau);
                            const float q = bf2f(QH[(size_t)t * 1024 + 128 * h + ch]); const float k = 1.f - __expf(gr[r]);
                            QT[tau * 136 + ch] = (bf16_t)f2bf(q * __expf(ar[r])); KBt[tau * 136 + ch] = (bf16_t)f2bf(k * __expf(-ar[r])); KHT[ch * 72 + tau] = (bf16_t)f2bf(k * __expf(aa - ar[r])); }
                    }
#pragma unroll
                    for (int j = 0; j < 2; ++j) { const int q = tid + 512 * j, tau = q >> 4, vc0 = (q & 15) * 8, t = z ? (t0 + 63 - tau) : (t0 + tau);
                        const bf16x8 v = *(const bf16x8*)(VH + (size_t)t * 1024 + 128 * h + vc0);
#pragma unroll
                        for (int e = 0; e < 8; ++e) VT[(vc0 + e) * 72 + tau] = (bf16_t)v[e]; }
                    {   const bf16_t* hs = HS + ((size_t)(z * 8 + h) * 128 + c) * 16384;
#pragma unroll
                        for (int j = 0; j < 4; ++j) { const int q = tid + 512 * j, vcol = q >> 4, kc = (q & 15) * 8; *(u32x4*)(ST + vcol * 136 + kc) = *(const u32x4*)(hs + vcol * 128 + kc); } }
                    __syncthreads();
                    f32x4 sacc[8];
#pragma unroll
                    for (int nb = 0; nb < 8; ++nb) { const u32x2 w = *(const u32x2*)(ST + (16 * nb + l15) * 136 + 16 * wave + l4 * 4); sacc[nb] = unpk4(w); }
#pragma unroll 1
                    for (int i = 0; i < 4; ++i) {
                        bf16x8 Aq[4];
#pragma unroll
                        for (int ks = 0; ks < 4; ++ks) Aq[ks] = *(const bf16x8*)(QT + (16 * i + l15) * 136 + 32 * ks + l4 * 8);
                        f32x4 o = (f32x4){0.f, 0.f, 0.f, 0.f}, att = (f32x4){0.f, 0.f, 0.f, 0.f};
#pragma unroll
                        for (int ks = 0; ks < 4; ++ks) { const bf16x8 Bs = *(const bf16x8*)(ST + (16 * wave + l15) * 136 + 32 * ks + l4 * 8); o = __builtin_amdgcn_mfma_f32_16x16x32_bf16(Aq[ks], Bs, o, 0, 0, 0); }
#pragma unroll
                        for (int ks = 0; ks < 4; ++ks) { const bf16x8 Bk = *(const bf16x8*)(KBt + (16 * i + l15) * 136 + 32 * ks + l4 * 8); att = __builtin_amdgcn_mfma_f32_16x16x32_bf16(Aq[ks], Bk, att, 0, 0, 0); }
#pragma unroll
                        for (int j = 0; j < 4; ++j) { const int tr = l4 * 4 + j; PW[tr * 16 + l15] = (bf16_t)f2bf((l15 <= tr) ? att[j] : 0.f); }
                        LDS_WAIT();
                        bf16x8 Ap = (bf16x8){0, 0, 0, 0, 0, 0, 0, 0}, Bv = (bf16x8){0, 0, 0, 0, 0, 0, 0, 0}, Ak = (bf16x8){0, 0, 0, 0, 0, 0, 0, 0};
                        if (lane < 32) { Ap = *(const bf16x8*)(PW + l15 * 16 + l4 * 8); Bv = *(const bf16x8*)(VT + (16 * wave + l15) * 72 + 16 * i + l4 * 8); Ak = *(const bf16x8*)(KHT + (16 * wave + l15) * 72 + 16 * i + l4 * 8); }
                        o = __builtin_amdgcn_mfma_f32_16x16x32_bf16(Ap, Bv, o, 0, 0, 0);
#pragma unroll
                        for (int j = 0; j < 4; ++j) { const int tau = 16 * i + l4 * 4 + j, tt = z ? (63 - tau) : tau; float* op = O + tt * 128 + 16 * wave + l15; if (z == 0) *op = o[j]; else *op += o[j]; }
                        if (i < 3) {
                            const f32x4 dv = *(const f32x4*)(Dd + i * 128 + 16 * wave + l4 * 4);
#pragma unroll
                            for (int nb = 0; nb < 8; ++nb) { bf16x8 Bn = (bf16x8){0, 0, 0, 0, 0, 0, 0, 0}; if (lane < 32) Bn = *(const bf16x8*)(VT + (16 * nb + l15) * 72 + 16 * i + l4 * 8);
                                sacc[nb] = __builtin_amdgcn_mfma_f32_16x16x32_bf16(Ak, Bn, sacc[nb] * dv, 0, 0, 0); }
                            __syncthreads();
#pragma unroll
                            for (int nb = 0; nb < 8; ++nb) *(u32x2*)(ST + (16 * nb + l15) * 136 + 16 * wave + l4 * 4) = pk4(sacc[nb]);
                            __syncthreads();
                        }
                    }
                }
                __syncthreads();
#pragma unroll 1
                for (int k2 = 0; k2 < 8; ++k2) { const int tt = 8 * wave + k2; const float v0 = O[tt * 128 + lane], v1 = O[tt * 128 + 64 + lane];
                    const float r = rsqrtf(wave_sum(v0 * v0 + v1 * v1) * (1.f / 128.f) + RMS_EPS); const size_t base = (size_t)(t0 + tt) * 1024 + 128 * h;
                    YH[base + lane] = (bf16_t)f2bf(v0 * r * hg_norm_g[lane] * bf2f(GH[base + lane]));
                    YH[base + 64 + lane] = (bf16_t)f2bf(v1 * r * hg_norm_g[64 + lane] * bf2f(GH[base + 64 + lane])); }
            }
            __syncthreads();
        }
    }
    SEAM(4);
    if (IN(5)) {
        pg8::Sched Sc; Sc.init(S, DM, 3, G, bid); Sc.A0 = (const char*)YH; Sc.a_z = 16L * 1024 * 1024; Sc.B = (const char*)WBR_T; Sc.a_pm = 256L * 1024 * 2; Sc.a_pn = 0; Sc.b_pn = 256L * 1024 * 2; Sc.b_z = 2048L * 1024 * 2;
        pg8::EpiMerge E{GS, MERGED, MERGEDB};
        pg8::gemm_phase<pg8::EpiMerge, true>(ldsl, 1024, 1024, 1024, Sc, E);
    }
    SEAM(5);
    if (IN(6)) {
        pg8::Sched Sc; Sc.init(S, DM, 1, G, bid); Sc.a_z = 0; Sc.A0 = (const char*)MERGEDB; Sc.B = (const char*)WO_T; Sc.a_pm = 256L * DM * 2; Sc.a_pn = 0; Sc.b_pn = 256L * DM * 2; Sc.b_z = 0;
        pg8::EpiWo E{x, STATS, ln_emb_g, ln_emb_b, R1};
        pg8::gemm_phase<pg8::EpiWo, true>(ldsl, DM, DM, DM, Sc, E);
    }
    SEAM(6);
    if (IN(7)) {
        for (int m = gw; m < S; m += NGW) ln_row(R1 + (size_t)m * DM, ln1_g, ln1_b, R1 + (size_t)m * DM, H1B + (size_t)m * DM, nullptr, lane);
        float* scr = (float*)lds + wave * (64 * 65);
        tr_mat(3, w_gate, w_up, DM, DFF, 2 * DFF, WGU_T, DM, nullptr, scr, lane, gw, NGW);
        tr_mat(0, w_down, w_down, DFF, DM, DM, WD_T, LDACT, nullptr, scr, lane, gw, NGW);
        __syncthreads();
    }
    SEAM(7);
    if (IN(8)) {
        pg8::Sched Sc; Sc.init(S, 2 * DFF, 1, G, bid); Sc.a_z = 0; Sc.A0 = (const char*)H1B; Sc.B = (const char*)WGU_T; Sc.a_pm = 256L * DM * 2; Sc.a_pn = 0; Sc.b_pn = 256L * DM * 2; Sc.b_z = 0;
        pg8::EpiGU E{ACT};
        pg8::gemm_phase<pg8::EpiGU, true>(ldsl, DM, DM, DM, Sc, E);
    }
    SEAM(8);
    if (IN(9)) {
        pg8::Sched Sc; Sc.init(S, DM, 1, G, bid); Sc.a_z = 0; Sc.A0 = (const char*)ACT; Sc.B = (const char*)WD_T; Sc.a_pm = 256L * LDACT * 2; Sc.a_pn = 0; Sc.b_pn = 256L * LDACT * 2; Sc.b_z = 0;
        pg8::EpiDown E{R1, out};
        pg8::gemm_phase<pg8::EpiDown, true>(ldsl, LDACT, LDACT, DFF, Sc, E);
    }
    SEAM(9);
    if (IN(10)) {
        for (int m = gw; m < S; m += NGW) ln_row(out + (size_t)m * DM, ln2_g, ln2_b, out + (size_t)m * DM, nullptr, nullptr, lane);
    }
#ifdef DBG_STOP
    {
        asm volatile("s_waitcnt vmcnt(0)" ::: "memory"); __threadfence(); grid.sync(); __builtin_amdgcn_fence(__ATOMIC_ACQUIRE, "agent"); asm volatile("s_waitcnt vmcnt(0)" ::: "memory");
        const size_t NO = (size_t)S * DM; const size_t gt = (size_t)bid * 512 + tid, NGT = (size_t)G * 512;
#define DB(ptr, n) for (size_t j = i; j < (size_t)(n); j += NO) acc += bf2f(((const bf16_t*)(ptr))[j]);
#define DF(ptr, n) for (size_t j = i; j < (size_t)(n); j += NO) acc += ((const float*)(ptr))[j];
        for (size_t i = gt; i < NO; i += NGT) { float acc = 0.f;
#if DBG_STOP == 0
            DB(WIN_T, 27787264) DB(H0B, 16777216) DB(WUQ_T, 786432) DB(WUKV_T, 1048576) DB(WKV_T, 4194304) DB(MEMB, 524288) DB(WBR_T, 6291456) DB(WO_T, 4194304) DF(STATS, 16384) DF(LB, 2048) DF(COS, 262144) DF(SIN, 262144)
#elif DBG_STOP == 1
            DB(QH, 8388608) DB(VH, 8388608) DB(GF, 16777216) DB(GH, 8388608) DB(CQ, 4194304) DB(CKV, 4194304) DB(QM, 8388608) DB(GS, 50331648) DB(KR, 524288) DB(KVM, 262144) DB(VMT, 262144) DF(SSQ, 131072)
#elif DBG_STOP == 2
            DB(QB, 12582912) DB(KB, 8388608) DB(VB, 8388608) DB(SC, 8388608) DB(HS, 33554432) DF(DVEC, 262144)
#elif DBG_STOP == 3
            DB(HS, 33554432) DB(PM, 8388608) DB(YA, 8388608)
#elif DBG_STOP == 4
            DB(YM, 8388608) DB(YH, 8388608)
#elif DBG_STOP == 5
            DB(MERGEDB, 16777216) DF(MERGED, 16777216)
#elif DBG_STOP == 6
            DF(R1, 16777216)
#elif DBG_STOP == 7
            DF(R1, 16777216) DB(H1B, 16777216) DB(WGU_T, 23068672) DB(WD_T, 11534336)
#elif DBG_STOP == 8
            DB(ACT, 46137344)
#endif
            out[i] = acc; }
    }
#endif
}

extern "C" void kernel_launch(void* const* d_in, const int* in_sizes, int n_in, void* d_out, int out_size, void* d_ws, size_t ws_size, hipStream_t stream) {
    static int grid = 0;
    if (grid == 0) {
        if (n_in != 22 || out_size != S * DM || ws_size < WS_END) { fprintf(stderr, "kernel_launch: unexpected shapes (n_in %d out %d ws %zu, need %zu)\n", n_in, out_size, ws_size, (size_t)WS_END); grid = -1; return; }
        int dev = 0, cus = 0, per_cu = 0;
        hipGetDevice(&dev); hipDeviceGetAttribute(&cus, hipDeviceAttributeMultiprocessorCount, dev);
        if (hipFuncSetAttribute((const void*)mega, hipFuncAttributeMaxDynamicSharedMemorySize, LDS_BYTES) != hipSuccess) { fprintf(stderr, "kernel_launch: hipFuncSetAttribute failed\n"); grid = -1; return; }
        if (hipOccupancyMaxActiveBlocksPerMultiprocessor(&per_cu, (const void*)mega, 512, LDS_BYTES) != hipSuccess || per_cu < 1) { fprintf(stderr, "kernel_launch: occupancy query failed (%d)\n", per_cu); per_cu = 1; (void)hipGetLastError(); }
        grid = cus * 1;
    }
    if (grid < 0) return;
    (void)hipMemsetAsync(d_ws, 0, 16384, stream);
    Args a{};
    for (int i = 0; i < 22; ++i) a.in[i] = (const float*)d_in[i];
    a.out = (float*)d_out; a.ws = (unsigned char*)d_ws; a.ph_lo = 0; a.ph_hi = 11;
#ifdef DBG_STOP
    a.ph_hi = DBG_STOP + 1;
#endif
    void* args[] = {&a};
#ifdef PROBE_K
    {   Args b = a; b.ph_hi = PROBE_K + 1; void* bargs[] = {&b};
        (void)hipLaunchCooperativeKernel((const void*)mega, dim3(grid), dim3(512), bargs, LDS_BYTES, stream); }
#endif
    hipError_t e = hipLaunchCooperativeKernel((const void*)mega, dim3(grid), dim3(512), args, LDS_BYTES, stream);
    if (e != hipSuccess) fprintf(stderr, "cooperative launch failed: %s (grid %d)\n", hipGetErrorString(e), grid);
}
```

```cpp
#include <hip/hip_runtime.h>
#include <hip/hip_cooperative_groups.h>
#include <cstdio>
#include <cstdint>
namespace cg = cooperative_groups;

#define LAS __attribute__((address_space(3)))
typedef unsigned short bf16_t;
typedef short bf16x8 __attribute__((ext_vector_type(8)));
typedef short s16x4 __attribute__((ext_vector_type(4)));
typedef float f32x4 __attribute__((ext_vector_type(4)));
typedef float f32x16 __attribute__((ext_vector_type(16)));
typedef unsigned u32x4 __attribute__((ext_vector_type(4)));
typedef unsigned u32x2 __attribute__((ext_vector_type(2)));

constexpr int S = 8192, DM = 2048, NMEM = 256, DFF = 5632;
constexpr int LD2K = 2112, LD1K = 1088;
constexpr int LDACT = 5696;
constexpr int NINP = 13568;
constexpr float ALPHA = 1.189207115002721f;
constexpr float LN_EPS = 1e-5f, RMS_EPS = 1e-6f;

constexpr size_t MiB = 1u << 20;
constexpr size_t WS_SSQ = 262144, WS_STATS = 65536, WS_LB = 131072;
constexpr size_t WS_COS = 1 * MiB, WS_SIN = 2 * MiB, WS_DVEC = 3 * MiB;
constexpr size_t WS_WIN_T = 4 * MiB, WS_H0B = 59 * MiB;
constexpr size_t WS_WUQ_T = 92 * MiB, WS_WUKV_T = 93 * MiB + 512 * 1024, WS_WKV_T = 95 * MiB + 512 * 1024, WS_MEMB = 103 * MiB + 512 * 1024;
constexpr size_t WS_KVM = 105 * MiB, WS_VMT = 105 * MiB + 512 * 1024, WS_KR = 106 * MiB;
constexpr size_t WS_QH = 107 * MiB, WS_VH = 123 * MiB, WS_GF = 139 * MiB, WS_GH = 171 * MiB;
constexpr size_t WS_CQ = 187 * MiB, WS_CKV = 195 * MiB, WS_QM = 203 * MiB, WS_GS = 219 * MiB;
constexpr size_t WS_HS = 315 * MiB, WS_YA = 86 * MiB, WS_WBR_T = 379 * MiB, WS_WO_T = 392 * MiB, WS_END = 401 * MiB;
constexpr size_t WS_KB = 4 * MiB, WS_VB = 20 * MiB, WS_QB = 36 * MiB, WS_SC = 60 * MiB;
constexpr size_t WS_PM = 187 * MiB;
constexpr size_t WS_YH = 52 * MiB, WS_YM = 69 * MiB;
constexpr size_t WS_MERGED = 107 * MiB, WS_MERGEDB = 171 * MiB;
constexpr size_t WS_R1 = 107 * MiB, WS_H1B = 171 * MiB;
constexpr size_t WS_WGU_T = 315 * MiB, WS_WD_T = 361 * MiB;
constexpr size_t WS_ACT = 219 * MiB;

constexpr int LDS_BYTES = 150 * 1024;

__device__ __forceinline__ float bf2f(bf16_t v) { return __uint_as_float((unsigned)v << 16); }
__device__ __forceinline__ unsigned f2bf(float f) { unsigned u = __float_as_uint(f); return (u + 0x7fffu + ((u >> 16) & 1u)) >> 16; }
__device__ __forceinline__ unsigned pk2(float lo, float hi) { return f2bf(lo) | (f2bf(hi) << 16); }
typedef __bf16 bf16x2_t __attribute__((ext_vector_type(2)));
typedef float f32x2_t __attribute__((ext_vector_type(2)));
__device__ __forceinline__ unsigned cvt_pk_bf16(float lo, float hi) { f32x2_t v = {lo, hi}; bf16x2_t b = __builtin_convertvector(v, bf16x2_t); return __builtin_bit_cast(unsigned, b); }
__device__ __forceinline__ u32x2 pk4(f32x4 v) { u32x2 w; w.x = cvt_pk_bf16(v[0], v[1]); w.y = cvt_pk_bf16(v[2], v[3]); return w; }
__device__ __forceinline__ f32x4 unpk4(u32x2 w) { f32x4 v; v[0] = __uint_as_float(w.x << 16); v[1] = __uint_as_float(w.x & 0xffff0000u); v[2] = __uint_as_float(w.y << 16); v[3] = __uint_as_float(w.y & 0xffff0000u); return v; }
__device__ __forceinline__ float wave_sum(float v) {
#pragma unroll
    for (int o = 1; o < 64; o <<= 1) v += __shfl_xor(v, o);
    return v;
}
__device__ __forceinline__ float wave_max(float v) {
#pragma unroll
    for (int o = 1; o < 64; o <<= 1) v = fmaxf(v, __shfl_xor(v, o));
    return v;
}
__device__ __forceinline__ float sigmoidf_(float v) { return __builtin_amdgcn_rcpf(1.f + __expf(-v)); }
#define LDS_WAIT() asm volatile("s_waitcnt lgkmcnt(0)" ::: "memory")

namespace pg8 {
constexpr int BM = 256, BK = 64, HALF = 128, HTB = HALF * BK * 2, STAGE_BYTES = 8 * HTB, NXCD = 8, WGM = 8;
__host__ __device__ __forceinline__ int lds_byte(int r, int c) { const int st = (r >> 4) * 2 + (c >> 5), rr = r & 15, cc = c & 31, ob = rr * 64 + cc * 2; return st * 1024 + (ob ^ (((ob >> 9) & 1) << 5)); }
__host__ __device__ __forceinline__ int perm32(int rho) { const int n = rho >> 4, i = rho & 15; return 8 * (i >> 2) + 4 * n + (i & 3); }
__host__ __device__ __forceinline__ void stage_rc(int b, int& R, int& C) { const int st = b / 1024, sb = b % 1024, swz = sb ^ (((sb >> 9) & 1) << 5); R = (st >> 1) * 16 + swz / 64; C = (st & 1) * 32 + (swz % 64) / 2; }

struct Unit { int pm, pn, z; };
struct Sched {
    int nM, nN, nZ, nwg, G, c;
    const char* A0; const char* B;
    long a_pm, a_pn, a_z, b_pn, b_z;
    __device__ __forceinline__ void init(int M, int N, int nZ_, int G_, int c_) { nM = M / BM; nN = N / BM; nZ = nZ_; nwg = nM * nN; G = G_; c = c_; }
    __device__ __forceinline__ bool next(int i, Unit& u) const {
        const int z = i % nZ; const long L = (long)(i / nZ) * G + c; if (L >= nwg) return false;
        int wgid = (int)L; { const int q = nwg / NXCD, r = nwg % NXCD, xcd = wgid % NXCD, off = wgid / NXCD; wgid = (xcd < r ? xcd * (q + 1) : r * (q + 1) + (xcd - r) * q) + off; }
        const int nig = WGM * nN, gid = wgid / nig, fm = gid * WGM, gsz = (nM - fm) < WGM ? (nM - fm) : WGM;
        u.pm = fm + ((wgid % nig) % gsz); u.pn = (wgid % nig) / gsz; u.z = z; return true;
    }
    __device__ __forceinline__ const char* aptr(const Unit& u) const { return A0 + u.pm * a_pm + u.pn * a_pn + u.z * a_z; }
    __device__ __forceinline__ const char* bptr(const Unit& u) const { return B + u.pn * b_pn + u.z * b_z; }
};

template <class Epi, bool ALIGN_EPI>
__device__ __forceinline__ void gemm_phase(LAS unsigned char* lds, const int lda, const int ldb, const int K, const Sched& S, const Epi& E) {
    const int tid = threadIdx.x, wid = __builtin_amdgcn_readfirstlane(tid >> 6), lane = tid & 63, wr = wid >> 2, wc = wid & 3, fr = lane & 15, fq = lane >> 4;
    const int nt = K / BK;
    unsigned voffA[2], voffB[2];
#pragma unroll
    for (int i = 0; i < 2; ++i) { int R, C; stage_rc(tid * 16 + i * 8192, R, C); const int Rb = Epi::PERM ? ((R & ~31) + perm32(R & 31)) : R; voffA[i] = (unsigned)(R * lda + C) * 2u; voffB[i] = (unsigned)(Rb * ldb + C) * 2u; }
    const size_t kstep = (size_t)(BK * 2);
    const size_t hstepA = (size_t)HALF * lda * 2, hstepB = (size_t)HALF * ldb * 2;
    const unsigned ldsw = (unsigned)wid * 1024u;
    const int aoff = lds_byte(wr * 64 + fr, fq * 8), boff = lds_byte(wc * 32 + fr, fq * 8);
#define PG8_SA(b, h) (((b) * 2 + (h)) * HTB)
#define PG8_SB(b, h) ((4 + (b) * 2 + (h)) * HTB)
#define PG8_STAGE(bufoff, gbase, voff) do { _Pragma("unroll") for (int _i = 0; _i < 2; ++_i) \
        __builtin_amdgcn_global_load_lds((const unsigned*)((const char*)(gbase) + (voff)[_i]), (LAS unsigned*)(lds + (bufoff) + ldsw + _i * 8192), 16, 0, 0); } while (0)
#define PG8_LDA(dst, b, h) do { _Pragma("unroll") for (int m = 0; m < 4; ++m) _Pragma("unroll") for (int k = 0; k < 2; ++k) dst[m][k] = *(const LAS bf16x8*)(lds + PG8_SA(b, h) + aoff + m * 2048 + k * 1024); } while (0)
#define PG8_LDB(dst, b, h) do { _Pragma("unroll") for (int n = 0; n < 2; ++n) _Pragma("unroll") for (int k = 0; k < 2; ++k) dst[n][k] = *(const LAS bf16x8*)(lds + PG8_SB(b, h) + boff + n * 2048 + k * 1024); } while (0)
#define PG8_MMA(ai, bj, At, Bt) do { __builtin_amdgcn_s_setprio(1); _Pragma("unroll") for (int m = 0; m < 4; ++m) _Pragma("unroll") for (int n = 0; n < 2; ++n) _Pragma("unroll") for (int k = 0; k < 2; ++k) \
        acc[ai][bj][m][n] = __builtin_amdgcn_mfma_f32_16x16x32_bf16(Bt[n][k], At[m][k], acc[ai][bj][m][n], 0, 0, 0); __builtin_amdgcn_s_setprio(0); } while (0)
#define PG8_WAIT_V(n) asm volatile("s_waitcnt vmcnt(" #n ")" ::: "memory")
#define PG8_WAIT_L(n) asm volatile("s_waitcnt lgkmcnt(" #n ")" ::: "memory")
#define PG8_BAR __builtin_amdgcn_s_barrier()
#define PG8_SCHED __builtin_amdgcn_sched_barrier(0)
    Unit cur, nxt; int ui = 0;
    if (!S.next(0, cur)) return;
    f32x4 acc[2][2][4][2];
#pragma unroll
    for (int a = 0; a < 2; ++a)
#pragma unroll
        for (int b = 0; b < 2; ++b)
#pragma unroll
            for (int m = 0; m < 4; ++m)
#pragma unroll
                for (int n = 0; n < 2; ++n) acc[a][b][m][n] = (f32x4){0.f, 0.f, 0.f, 0.f};
    bf16x8 At[4][2], B0[2][2], B1[2][2];
    const char* cA = S.aptr(cur); const char* cB = S.bptr(cur);
    PG8_STAGE(PG8_SB(0, 0), cB, voffB); PG8_STAGE(PG8_SB(0, 1), cB + hstepB, voffB); PG8_STAGE(PG8_SA(0, 0), cA, voffA); PG8_STAGE(PG8_SA(0, 1), cA + hstepA, voffA);
    if (wr == 1) PG8_BAR;
    PG8_WAIT_V(2); PG8_BAR;
    PG8_STAGE(PG8_SB(1, 0), cB + kstep, voffB); PG8_STAGE(PG8_SA(1, 0), cA + kstep, voffA); PG8_STAGE(PG8_SB(1, 1), cB + hstepB + kstep, voffB);
    PG8_WAIT_V(6); PG8_BAR;
    for (;;) {
        const bool has_next = S.next(ui + 1, nxt);
        const char* nA = has_next ? S.aptr(nxt) : cA; const char* nB = has_next ? S.bptr(nxt) : cB;
        for (int t = 0; t < nt; t += 2) {
            const bool last = (t == nt - 2);
            const char* a1 = cA + (size_t)(t + 1) * kstep;
            const char* a2 = last ? nA : cA + (size_t)(t + 2) * kstep; const char* b2 = last ? nB : cB + (size_t)(t + 2) * kstep;
            const char* a3 = a2 + kstep; const char* b3 = b2 + kstep;
            PG8_LDB(B0, 0, 0); PG8_LDB(B1, 0, 1); PG8_SCHED; PG8_LDA(At, 0, 0); PG8_STAGE(PG8_SA(1, 1), a1 + hstepA, voffA);
            PG8_WAIT_V(8); PG8_WAIT_L(0); PG8_BAR; PG8_MMA(0, 0, At, B0); PG8_MMA(0, 1, At, B1); PG8_BAR; PG8_SCHED;
            PG8_LDA(At, 0, 1); PG8_STAGE(PG8_SB(0, 0), b2, voffB); PG8_STAGE(PG8_SB(0, 1), b2 + hstepB, voffB); PG8_STAGE(PG8_SA(0, 0), a2, voffA);
            PG8_WAIT_V(8); PG8_WAIT_L(0); PG8_BAR; PG8_MMA(1, 0, At, B0); PG8_MMA(1, 1, At, B1); PG8_BAR; PG8_SCHED;
            PG8_LDB(B0, 1, 0); PG8_LDB(B1, 1, 1); PG8_SCHED; PG8_LDA(At, 1, 0); PG8_STAGE(PG8_SA(0, 1), a2 + hstepA, voffA);
            PG8_WAIT_V(8); PG8_WAIT_L(0); PG8_BAR; PG8_MMA(0, 0, At, B0); PG8_MMA(0, 1, At, B1); PG8_BAR; PG8_SCHED;
            PG8_LDA(At, 1, 1); PG8_STAGE(PG8_SB(1, 0), b3, voffB); PG8_STAGE(PG8_SB(1, 1), b3 + hstepB, voffB); PG8_STAGE(PG8_SA(1, 0), a3, voffA);
            PG8_WAIT_V(8); PG8_WAIT_L(0); PG8_BAR; PG8_MMA(1, 0, At, B0); PG8_MMA(1, 1, At, B1); PG8_BAR; PG8_SCHED;
        }
        if constexpr (ALIGN_EPI) { if (wr == 0) PG8_BAR; }
        E(acc, cur, wr, wc, fr, fq);
        if (!has_next) break;
#pragma unroll
        for (int a = 0; a < 2; ++a)
#pragma unroll
            for (int b = 0; b < 2; ++b)
#pragma unroll
                for (int m = 0; m < 4; ++m)
#pragma unroll
                    for (int n = 0; n < 2; ++n) acc[a][b][m][n] = (f32x4){0.f, 0.f, 0.f, 0.f};
        cur = nxt; cA = nA; cB = nB; ++ui;
        if constexpr (ALIGN_EPI) { if (wr == 1) PG8_BAR; }
    }
    PG8_WAIT_V(0);
    if constexpr (!ALIGN_EPI) { if (wr == 0) PG8_BAR; }
    PG8_BAR;
#undef PG8_SA
#undef PG8_SB
#undef PG8_STAGE
#undef PG8_LDA
#undef PG8_LDB
#undef PG8_MMA
#undef PG8_WAIT_V
#undef PG8_WAIT_L
#undef PG8_BAR
#undef PG8_SCHED
}

__device__ __forceinline__ u32x4 pk8(f32x4 a, f32x4 b) { u32x4 w; w.x = cvt_pk_bf16(a[0], a[1]); w.y = cvt_pk_bf16(a[2], a[3]); w.z = cvt_pk_bf16(b[0], b[1]); w.w = cvt_pk_bf16(b[2], b[3]); return w; }
#define EPI_ARGS const f32x4 (&acc)[2][2][4][2], const Unit& u, int wr, int wc, int fr, int fq
#define EPI_ROWS for (int ai = 0; ai < 2; ++ai) for (int m = 0; m < 4; ++m)
#define EPI_COLS for (int bj = 0; bj < 2; ++bj) for (int n = 0; n < 2; ++n)

struct EpiStore {
    static constexpr bool PERM = true;
    bf16_t* O; int ldc; float scale;
    __device__ __forceinline__ void operator()(EPI_ARGS) const {
        const int row0 = u.pm * BM + wr * 64 + fr, col0 = u.pn * BM + wc * 32 + 8 * fq;
#pragma unroll
        EPI_ROWS { bf16_t* rp = O + (size_t)(row0 + ai * HALF + m * 16) * ldc + col0;
#pragma unroll
            for (int bj = 0; bj < 2; ++bj) *(u32x4*)(rp + bj * HALF) = pk8(acc[ai][bj][m][0] * scale, acc[ai][bj][m][1] * scale); }
    }
};

struct EpiP1 {
    static constexpr bool PERM = true;
    bf16_t *QH, *VH, *GF, *GH, *CQ, *CKV, *QM, *GS, *KR; float* SSQ; const float *LB, *COS, *SIN;
    __device__ __forceinline__ void operator()(EPI_ARGS) const {
        const int pn = u.pn; const int row0 = u.pm * BM + wr * 64 + fr; const int ct = wc * 32 + 8 * fq;
        if (pn == 52) {
            if (wc < 2) {
                const int i0 = 16 * wc + 4 * fq;
#pragma unroll
                EPI_ROWS { const int row = row0 + ai * HALF + m * 16;
                    const f32x4 cs = *(const f32x4*)(COS + (size_t)row * 32 + i0), sn = *(const f32x4*)(SIN + (size_t)row * 32 + i0);
                    const f32x4 x1 = acc[ai][0][m][0], x2 = acc[ai][0][m][1];
                    const f32x4 o1 = x1 * cs - x2 * sn, o2 = x2 * cs + x1 * sn;
                    bf16_t* rp = KR + (size_t)row * 64 + 32 * wc + 4 * fq;
                    *(u32x2*)(rp) = pk4(o1); *(u32x2*)(rp + 16) = pk4(o2); }
            }
            return;
        }
        int op, ld, c0, ssq = -1; bf16_t* dst; const float* lbp = nullptr;
        if (pn < 4) { op = 1; dst = QH; ld = 1024; c0 = 256 * pn; }
        else if (pn < 8) { op = 0; dst = VH; ld = 1024; c0 = 256 * (pn - 4); }
        else if (pn < 16) { const int z = (pn >= 12) ? 1 : 0; op = 3; dst = GF + (size_t)z * S * 1024; ld = 1024; c0 = 256 * ((pn - 8) & 3); lbp = LB + z * 1024 + c0 + ct; }
        else if (pn < 20) { op = 2; dst = GH; ld = 1024; c0 = 256 * (pn - 16); }
        else if (pn < 22) { op = 0; dst = CQ; ld = 512; c0 = 256 * (pn - 20); ssq = 0; }
        else if (pn < 24) { op = 0; dst = CKV; ld = 512; c0 = 256 * (pn - 22); ssq = 1; }
        else if (pn < 28) { op = 0; dst = QM; ld = 1024; c0 = 256 * (pn - 24); }
        else { op = 2; dst = GS; ld = 6144; c0 = 256 * (pn - 28); }
        f32x4 lbv[2][2];
#pragma unroll
        EPI_COLS lbv[bj][n] = (op == 3) ? *(const f32x4*)(lbp + bj * HALF + n * 4) : (f32x4){0.f, 0.f, 0.f, 0.f};
#pragma unroll
        EPI_ROWS { const int row = row0 + ai * HALF + m * 16; bf16_t* rp = dst + (size_t)row * ld + c0 + ct; float ss = 0.f;
#pragma unroll
            for (int bj = 0; bj < 2; ++bj) { f32x4 vv[2];
#pragma unroll
                for (int n = 0; n < 2; ++n) { f32x4 v = acc[ai][bj][m][n];
                    if (op != 0) {
#pragma unroll
                        for (int e = 0; e < 4; ++e) { const float x = v[e]; const float sg = sigmoidf_(x);
                            float r = sg; if (op == 1) r = x * sg; else if (op == 3) { const float lb = lbv[bj][n][e]; r = __logf(lb + (1.f - lb) * sg); }
                            v[e] = r; }
                    }
                    ss += (v[0] * v[0] + v[1] * v[1]) + (v[2] * v[2] + v[3] * v[3]); vv[n] = v; }
                *(u32x4*)(rp + bj * HALF) = pk8(vv[0], vv[1]); }
            if (ssq >= 0) { ss += __shfl_xor(ss, 16); ss += __shfl_xor(ss, 32); if (fq == 0) SSQ[((size_t)ssq * S + row) * 8 + (pn & 1) * 4 + wc] = ss; }
        }
    }
};

struct EpiQ {
    static constexpr bool PERM = false;
    bf16_t* QB; const float *SSQ, *COS, *SIN;
    __device__ __forceinline__ void operator()(EPI_ARGS) const {
        const int row0 = u.pm * BM + wr * 64 + fr;
#pragma unroll
        EPI_ROWS { const int row = row0 + ai * HALF + m * 16; const f32x4 sa = *(const f32x4*)(SSQ + (size_t)row * 8), sb2 = *(const f32x4*)(SSQ + (size_t)row * 8 + 4); const float rstd = rsqrtf((((sa[0] + sa[1]) + (sa[2] + sa[3])) + ((sb2[0] + sb2[1]) + (sb2[2] + sb2[3]))) * (1.f / 512.f) + RMS_EPS);
#pragma unroll
            for (int bj = 0; bj < 2; ++bj) { const int gg = 8 * u.pn + 4 * bj + wc, part = gg % 6;
                f32x4 x1 = acc[ai][bj][m][0] * rstd, x2 = acc[ai][bj][m][1] * rstd;
                if (part >= 4) { const int i0 = (part - 4) * 16 + 4 * fq;
                    const f32x4 cs = *(const f32x4*)(COS + (size_t)row * 32 + i0), sn = *(const f32x4*)(SIN + (size_t)row * 32 + i0);
                    const f32x4 o1 = x1 * cs - x2 * sn, o2 = x2 * cs + x1 * sn; x1 = o1; x2 = o2; }
                bf16_t* rp = QB + (size_t)row * 1536 + 32 * gg + 4 * fq;
                *(u32x2*)(rp) = pk4(x1); *(u32x2*)(rp + 16) = pk4(x2); } }
    }
};
struct EpiKV {
    static constexpr bool PERM = false;
    bf16_t *KB, *VB; const float* SSQ;
    __device__ __forceinline__ void operator()(EPI_ARGS) const {
        const int row0 = u.pm * BM + wr * 64 + fr; const int c = u.pn * 128 + wc * 32 + 4 * fq;
#pragma unroll
        EPI_ROWS { const int row = row0 + ai * HALF + m * 16; const f32x4 sa = *(const f32x4*)(SSQ + (size_t)row * 8), sb2 = *(const f32x4*)(SSQ + (size_t)row * 8 + 4); const float rstd = rsqrtf((((sa[0] + sa[1]) + (sa[2] + sa[3])) + ((sb2[0] + sb2[1]) + (sb2[2] + sb2[3]))) * (1.f / 512.f) + RMS_EPS);
#pragma unroll
            for (int n = 0; n < 2; ++n) { *(u32x2*)(KB + (size_t)row * 1024 + c + 16 * n) = pk4(acc[ai][0][m][n] * rstd); *(u32x2*)(VB + (size_t)row * 1024 + c + 16 * n) = pk4(acc[ai][1][m][n] * rstd); } }
    }
};
struct EpiMerge {
    static constexpr bool PERM = true;
    const bf16_t* GS; float* MG; bf16_t* MGB;
    __device__ __forceinline__ void operator()(EPI_ARGS) const {
        const int row0 = u.pm * BM + wr * 64 + fr, col0 = u.pn * BM + wc * 32 + 8 * fq; const int z = u.z, gz = (3 - z) % 3;
#pragma unroll
        EPI_ROWS { const size_t row = (size_t)(row0 + ai * HALF + m * 16);
#pragma unroll
            for (int bj = 0; bj < 2; ++bj) { const int col = col0 + bj * HALF;
                const u32x4 gw4 = *(const u32x4*)(GS + row * 6144 + gz * 2048 + col);
                u32x2 g0; g0.x = gw4.x; g0.y = gw4.y; u32x2 g1; g1.x = gw4.z; g1.y = gw4.w;
                f32x4 v0 = unpk4(g0) * acc[ai][bj][m][0], v1 = unpk4(g1) * acc[ai][bj][m][1];
                if (z > 0) { v0 += *(const f32x4*)(MG + row * DM + col); v1 += *(const f32x4*)(MG + row * DM + col + 4); }
                if (z < 2) { *(f32x4*)(MG + row * DM + col) = v0; *(f32x4*)(MG + row * DM + col + 4) = v1; } else *(u32x4*)(MGB + row * LD2K + col) = pk8(v0, v1); } }
    }
};
struct EpiWo {
    static constexpr bool PERM = true;
    const float *X, *STATS, *G, *Bv; float* R1;
    __device__ __forceinline__ void operator()(EPI_ARGS) const {
        const int row0 = u.pm * BM + wr * 64 + fr, col0 = u.pn * BM + wc * 32 + 8 * fq;
        f32x4 gv[2][2], bv[2][2];
#pragma unroll
        EPI_COLS { gv[bj][n] = *(const f32x4*)(G + col0 + bj * HALF + n * 4); bv[bj][n] = *(const f32x4*)(Bv + col0 + bj * HALF + n * 4); }
#pragma unroll
        EPI_ROWS { const size_t row = (size_t)(row0 + ai * HALF + m * 16); const float mean = STATS[2 * row], rstd = STATS[2 * row + 1];
#pragma unroll
            EPI_COLS { const int col = col0 + bj * HALF + n * 4; const f32x4 x = *(const f32x4*)(X + row * DM + col);
                const f32x4 h = (x - mean) * rstd * gv[bj][n] + bv[bj][n];
                *(f32x4*)(R1 + row * DM + col) = h * ALPHA + acc[ai][bj][m][n]; } }
    }
};
struct EpiGU {
    static constexpr bool PERM = true;
    bf16_t* ACT;
    __device__ __forceinline__ void operator()(EPI_ARGS) const {
        const int row0 = u.pm * BM + wr * 64 + fr;
#pragma unroll
        EPI_ROWS { const size_t row = (size_t)(row0 + ai * HALF + m * 16);
#pragma unroll
            for (int bj = 0; bj < 2; ++bj) { const int grp = 8 * u.pn + 4 * bj + wc; const f32x4 g = acc[ai][bj][m][0], up = acc[ai][bj][m][1]; f32x4 o;
#pragma unroll
                for (int e = 0; e < 4; ++e) o[e] = g[e] * sigmoidf_(g[e]) * up[e];
                *(u32x2*)(ACT + row * LDACT + 16 * grp + 4 * fq) = pk4(o); } }
    }
};
struct EpiDown {
    static constexpr bool PERM = true;
    const float* H1; float* OUT;
    __device__ __forceinline__ void operator()(EPI_ARGS) const {
        const int row0 = u.pm * BM + wr * 64 + fr, col0 = u.pn * BM + wc * 32 + 8 * fq;
#pragma unroll
        EPI_ROWS { const size_t row = (size_t)(row0 + ai * HALF + m * 16);
#pragma unroll
            EPI_COLS { const int col = col0 + bj * HALF + n * 4; *(f32x4*)(OUT + row * DM + col) = *(const f32x4*)(H1 + row * DM + col) * ALPHA + acc[ai][bj][m][n]; } }
    }
};
}

namespace mla {
constexpr int NW = 8, QBLK = 32, KVBLK = 64;
constexpr float SCALE = 0.07216878364870322f;
constexpr float THR = 8.f;
constexpr int LDQ = 1536, LDKN = 1024, LDKR = 64, LDV = 1024, LDO = LD1K;
constexpr int SHM_V = 64 * 128 * 2, SHM_K = 64 * 192 * 2;
#define KSWZ(row, colB) ((row) * 384 + ((colB) ^ (((row) & 7) << 4)))
#define SBAR() __builtin_amdgcn_sched_barrier(0)
__device__ __forceinline__ int crow(int r, int hi) { return (r & 3) + 8 * (r >> 2) + 4 * hi; }
__device__ __forceinline__ unsigned cvtpk(float lo, float hi) { unsigned r; asm volatile("v_cvt_pk_bf16_f32 %0, %1, %2" : "=v"(r) : "v"(lo), "v"(hi)); return r; }

__device__ __forceinline__ void partialSM(f32x16& p0, f32x16& p1, float& m_reg, float& mn, float& alpha) {
    constexpr float C = SCALE * 1.4426950408889634f;
    float pmax = p0[0];
#pragma unroll
    for (int r = 1; r < 16; ++r) pmax = fmaxf(pmax, p0[r]);
#pragma unroll
    for (int r = 0; r < 16; ++r) pmax = fmaxf(pmax, p1[r]);
    { auto rr = __builtin_amdgcn_permlane32_swap(__float_as_uint(pmax), __float_as_uint(pmax), false, false);
      pmax = fmaxf(__uint_as_float(rr[0]), __uint_as_float(rr[1])); }
    if (__builtin_expect(__all(pmax - m_reg <= THR / SCALE), 1)) { mn = m_reg; alpha = 1.f; }
    else { mn = fmaxf(m_reg, pmax); alpha = __builtin_amdgcn_exp2f((m_reg - mn) * C); m_reg = mn; }
    float mnC = -mn * C;
#pragma unroll
    for (int r = 0; r < 16; ++r) p0[r] = fmaf(p0[r], C, mnC);
#pragma unroll
    for (int r = 0; r < 16; ++r) p1[r] = fmaf(p1[r], C, mnC);
#pragma unroll
    for (int r = 0; r < 16; ++r) p0[r] = __builtin_amdgcn_exp2f(p0[r]);
}
__device__ __forceinline__ void finishSM(f32x16& p0, f32x16& p1, float alpha, float& l_reg, bf16x8& pa0, bf16x8& pa1, bf16x8& pa2, bf16x8& pa3) {
#pragma unroll
    for (int r = 0; r < 16; ++r) p1[r] = __builtin_amdgcn_exp2f(p1[r]);
    float ps = 0;
#pragma unroll
    for (int r = 0; r < 16; ++r) ps += p0[r];
#pragma unroll
    for (int r = 0; r < 16; ++r) ps += p1[r];
    { auto rr = __builtin_amdgcn_permlane32_swap(__float_as_uint(ps), __float_as_uint(ps), false, false);
      ps = __uint_as_float(rr[0]) + __uint_as_float(rr[1]); }
    l_reg = l_reg * alpha + ps;
#define PK4(P, BASE, OUT) do { unsigned a0 = cvtpk(P[BASE + 0], P[BASE + 1]), a1 = cvtpk(P[BASE + 2], P[BASE + 3]);   \
    unsigned b0 = cvtpk(P[BASE + 4], P[BASE + 5]), b1 = cvtpk(P[BASE + 6], P[BASE + 7]);                              \
    auto r0 = __builtin_amdgcn_permlane32_swap(a0, b0, false, false); auto r1 = __builtin_amdgcn_permlane32_swap(a1, b1, false, false); \
    u32x4 w = {r0[0], r1[0], r0[1], r1[1]}; OUT = *reinterpret_cast<bf16x8*>(&w); } while (0)
    PK4(p0, 0, pa0); PK4(p0, 8, pa1); PK4(p1, 0, pa2); PK4(p1, 8, pa3);
#undef PK4
}
__device__ __forceinline__ void qkt(f32x16& p0, f32x16& p1, const char* Ks, const bf16x8* qr, int r32, int hi) {
    p0 = f32x16{}; p1 = f32x16{};
#pragma unroll
    for (int d0 = 0; d0 < 12; ++d0) { int cb = (d0 * 16 + hi * 8) * 2;
        bf16x8 b0 = *reinterpret_cast<const bf16x8*>(Ks + KSWZ(r32, cb));
        bf16x8 b1 = *reinterpret_cast<const bf16x8*>(Ks + KSWZ(32 + r32, cb));
        p0 = __builtin_amdgcn_mfma_f32_32x32x16_bf16(b0, qr[d0], p0, 0, 0, 0);
        p1 = __builtin_amdgcn_mfma_f32_32x32x16_bf16(b1, qr[d0], p1, 0, 0, 0); }
}
__device__ __forceinline__ int v_st(int k, int c) { const int kk = (k & ~0xC) | ((k & 4) << 1) | ((k & 8) >> 1); return ((kk >> 3) * 4 + (c >> 5)) * 512 + ((kk & 7) * 32 + (c & 31)) * 2; }
__device__ __forceinline__ int v_rd_base(int lane) { return ((lane & 3) << 3) | (((lane >> 2) & 3) << 6) | (((lane >> 4) & 1) << 5) | (((lane >> 5) & 1) << 8); }
constexpr int v_rd_off(int d0, int ks, int half) { return d0 * 512 + ks * 4096 + half * 2048; }
template <int OFF> __device__ __forceinline__ s16x4 tr_read(int vb) {
    s16x4 r; asm volatile("ds_read_b64_tr_b16 %0, %1 offset:%2" : "=&v"(r) : "v"(vb), "i"(OFF) : "memory"); return r;
}
template <int D0> __device__ __forceinline__ void pv_one(f32x16& od, int vb, bf16x8 pa0, bf16x8 pa1, bf16x8 pa2, bf16x8 pa3) {
    const s16x4 l0 = tr_read<v_rd_off(D0, 0, 0)>(vb), h0 = tr_read<v_rd_off(D0, 0, 1)>(vb), l1 = tr_read<v_rd_off(D0, 1, 0)>(vb), h1 = tr_read<v_rd_off(D0, 1, 1)>(vb);
    const s16x4 l2 = tr_read<v_rd_off(D0, 2, 0)>(vb), h2 = tr_read<v_rd_off(D0, 2, 1)>(vb), l3 = tr_read<v_rd_off(D0, 3, 0)>(vb), h3 = tr_read<v_rd_off(D0, 3, 1)>(vb);
    asm volatile("s_waitcnt lgkmcnt(0)" ::: "memory"); SBAR();
#define PK(L, H) (bf16x8){L[0], L[1], L[2], L[3], H[0], H[1], H[2], H[3]}
    od = __builtin_amdgcn_mfma_f32_32x32x16_bf16(pa0, PK(l0, h0), od, 0, 0, 0);
    od = __builtin_amdgcn_mfma_f32_32x32x16_bf16(pa1, PK(l1, h1), od, 0, 0, 0);
    od = __builtin_amdgcn_mfma_f32_32x32x16_bf16(pa2, PK(l2, h2), od, 0, 0, 0);
    od = __builtin_amdgcn_mfma_f32_32x32x16_bf16(pa3, PK(l3, h3), od, 0, 0, 0);
#undef PK
}
__device__ __forceinline__ void pv_d0(f32x16* o, int vb, bf16x8 pa0, bf16x8 pa1, bf16x8 pa2, bf16x8 pa3) {
    pv_one<0>(o[0], vb, pa0, pa1, pa2, pa3); pv_one<1>(o[1], vb, pa0, pa1, pa2, pa3); pv_one<2>(o[2], vb, pa0, pa1, pa2, pa3); pv_one<3>(o[3], vb, pa0, pa1, pa2, pa3);
}

__device__ __forceinline__ void attn_unit(const bf16_t* __restrict__ Qb, const bf16_t* __restrict__ Kn, const bf16_t* __restrict__ Kr, const bf16_t* __restrict__ Vh,
                                          bf16_t* __restrict__ Ob, int seq, char* lds) {
    const int tid = threadIdx.x, wid = tid >> 6, lane = tid & 63, r32 = lane & 31, hi = lane >> 5;
    char* V_lds = lds; char* K_lds = lds + 2 * SHM_V;
    float* ws = (float*)(lds + 2 * SHM_V + 2 * SHM_K) + wid * 64; float* li_l = ws; float* al_l = ws + 32;
    float m_reg = -1e30f, l_reg = 0; f32x16 o[4] = {}; bf16x8 qr[12];
    const bf16_t* Qw = Qb + (long)(wid * QBLK + r32) * LDQ + hi * 8;
#pragma unroll
    for (int d0 = 0; d0 < 12; ++d0) qr[d0] = *reinterpret_cast<const bf16x8*>(Qw + d0 * 16);
    const int sr = tid >> 4, sc = (tid & 15) * 8, vst0 = v_st(sr, sc), vst1 = v_st(32 + sr, sc);
    const int vb0 = (int)(uintptr_t)V_lds + v_rd_base(lane);
    const bf16_t* kp[3]; int kstr[3], kst[3];
#pragma unroll
    for (int i = 0; i < 3; ++i) { const int q = tid + 512 * i, row = q / 24, cc = q % 24;
        kp[i] = (cc < 16) ? (Kn + (long)row * LDKN + cc * 8) : (Kr + (long)row * LDKR + (cc - 16) * 8); kstr[i] = (cc < 16) ? LDKN : LDKR; kst[i] = KSWZ(row, cc * 16); }
    bf16x8 vs0, vs1, ks0, ks1, ks2;
#define SLOAD(k0) do { vs0 = *reinterpret_cast<const bf16x8*>(&Vh[(long)((k0) + sr) * LDV + sc]); vs1 = *reinterpret_cast<const bf16x8*>(&Vh[(long)((k0) + 32 + sr) * LDV + sc]); \
    ks0 = *reinterpret_cast<const bf16x8*>(kp[0] + (long)(k0) * kstr[0]); ks1 = *reinterpret_cast<const bf16x8*>(kp[1] + (long)(k0) * kstr[1]); ks2 = *reinterpret_cast<const bf16x8*>(kp[2] + (long)(k0) * kstr[2]); } while (0)
#define SWRITE(b) do { *(bf16x8*)(V_lds + (b) * SHM_V + vst0) = vs0; *(bf16x8*)(V_lds + (b) * SHM_V + vst1) = vs1; \
    *(bf16x8*)(K_lds + (b) * SHM_K + kst[0]) = ks0; *(bf16x8*)(K_lds + (b) * SHM_K + kst[1]) = ks1; *(bf16x8*)(K_lds + (b) * SHM_K + kst[2]) = ks2; } while (0)
#define SWAIT() asm volatile("s_waitcnt vmcnt(0)" ::: "memory")
#define RESC(a) do { if (__any((a) < 1.f)) { if (hi == 0) al_l[r32] = (a); asm volatile("s_waitcnt lgkmcnt(0)" ::: "memory"); \
    _Pragma("unroll") for (int d = 0; d < 4; ++d) _Pragma("unroll") for (int r = 0; r < 16; ++r) o[d][r] *= al_l[crow(r, hi)]; } } while (0)
    f32x16 pA0, pA1; float mnA, alA; bf16x8 pa0, pa1, pa2, pa3; const int NT = seq / KVBLK;
    SLOAD(0); SWAIT(); SWRITE(0); __syncthreads();
#pragma unroll 1
    for (int j = 0; j < NT; ++j) {
        const int buf = j & 1;
        if (j + 1 < NT) SLOAD((j + 1) * KVBLK);
        SBAR(); qkt(pA0, pA1, K_lds + buf * SHM_K, qr, r32, hi);
        partialSM(pA0, pA1, m_reg, mnA, alA);
        RESC(alA);
        finishSM(pA0, pA1, alA, l_reg, pa0, pa1, pa2, pa3); SBAR();
        pv_d0(o, vb0 + buf * (int)SHM_V, pa0, pa1, pa2, pa3);
        if (j + 1 < NT) { SWAIT(); SWRITE(buf ^ 1); }
        __syncthreads();
    }
    if (hi == 0) li_l[r32] = l_reg; asm volatile("s_waitcnt lgkmcnt(0)" ::: "memory");
    float rli[16];
#pragma unroll
    for (int r = 0; r < 16; ++r) rli[r] = __builtin_amdgcn_rcpf(li_l[crow(r, hi)]);
    bf16_t* Ow = Ob + (long)(wid * QBLK) * LDO;
#pragma unroll
    for (int r = 0; r < 16; ++r) { int orow = crow(r, hi);
#pragma unroll
        for (int d0 = 0; d0 < 4; ++d0) Ow[(long)orow * LDO + d0 * 32 + r32] = (bf16_t)f2bf(o[d0][r] * rli[r]); }
    __syncthreads();
#undef SLOAD
#undef SWRITE
#undef SWAIT
#undef RESC
}
#undef SBAR
}

#define XB_TMO      128
#define XB_XCNT(j)  (256  + 64 * (j))
#define XB_XSUB(j)  (1280 + 64 * (j))
#define XB_XGEN(j)  (2304 + 64 * (j))
#define XB_TOP      3328
#define XB_TOPGEN   3392
#define XCD_BAR_WORDS 3456
#define XB_SPIN_CAP (1u << 22)
__device__ __forceinline__ unsigned xb_ld(unsigned* p)              { return __hip_atomic_load(p, __ATOMIC_RELAXED, __HIP_MEMORY_SCOPE_AGENT); }
__device__ __forceinline__ unsigned xb_add(unsigned* p, unsigned v) { return __hip_atomic_fetch_add(p, v, __ATOMIC_RELAXED, __HIP_MEMORY_SCOPE_AGENT); }
__device__ __forceinline__ unsigned xb_xcc_id() { return (unsigned)__builtin_amdgcn_s_getreg((3 << 11) | 20) & 0xFu; }
#define XB_SPIN(cond, bar) do { unsigned _sp = 0; while (cond) { __builtin_amdgcn_s_sleep(1); \
    if ((++_sp & 255u) == 0u) { if (xb_ld(&(bar)[XB_TMO])) break; if (_sp > XB_SPIN_CAP) { atomicAdd(&(bar)[XB_TMO], 1u); break; } } } } while (0)
struct XcdBarrier { unsigned* bar; unsigned x; volatile LAS unsigned* st; };
__device__ __forceinline__ XcdBarrier xcd_barrier_post(unsigned* bar, volatile LAS unsigned* st) {
    XcdBarrier b; b.bar = bar; b.x = xb_xcc_id(); b.st = st;
    if (threadIdx.x == 0) (void)xb_add(&bar[XB_XCNT(b.x)], 1u);
    return b;
}
__device__ __forceinline__ void xcd_barrier_complete(unsigned* bar, unsigned x, unsigned& nloc, unsigned& nx) {
    const unsigned G = gridDim.x * gridDim.y * gridDim.z;
    unsigned sum, cnt, mine, sp = 0u;
    for (;;) {
        sum = 0u; cnt = 0u; mine = 0u;
#pragma unroll
        for (unsigned j = 0; j < 16; ++j) { const unsigned c = xb_ld(&bar[XB_XCNT(j)]); sum += c; cnt += (c > 0u) ? 1u : 0u; mine = (j == x) ? c : mine; }
        if (sum == G) break;
        __builtin_amdgcn_s_sleep(1);
        if ((++sp & 255u) == 0u) { if (xb_ld(&bar[XB_TMO])) break; if (sp > XB_SPIN_CAP) { atomicAdd(&bar[XB_TMO], 1u); break; } }
    }
    nloc = mine > 0u ? mine : 1u; nx = cnt > 0u ? cnt : 1u;
}
__device__ __forceinline__ void xcd_barrier(const XcdBarrier& b) {
    asm volatile("s_waitcnt vmcnt(0)" ::: "memory");
    __syncthreads();
    if (threadIdx.x == 0) {
        unsigned* bar = b.bar;
        __builtin_amdgcn_s_waitcnt(0);
        unsigned nloc = b.st[0], nx = b.st[1];
        if (nloc == 0u) { xcd_barrier_complete(bar, b.x, nloc, nx); b.st[0] = nloc; b.st[1] = nx; }
        const unsigned old = xb_add(&bar[XB_XSUB(b.x)], 1u);
        const unsigned gen = old / nloc;
        if (old + 1u == (gen + 1u) * nloc) {
            __builtin_amdgcn_fence(__ATOMIC_RELEASE, "agent");
            asm volatile("s_waitcnt vmcnt(0)" ::: "memory");
            const unsigned og = xb_add(&bar[XB_TOP], 1u);
            const unsigned tg = og / nx;
            if (og + 1u == (tg + 1u) * nx) xb_add(&bar[XB_TOPGEN], 1u);
            else XB_SPIN(xb_ld(&bar[XB_TOPGEN]) == tg, bar);
            __builtin_amdgcn_fence(__ATOMIC_ACQUIRE, "agent");
            xb_add(&bar[XB_XGEN(b.x)], 1u);
            asm volatile("s_waitcnt vmcnt(0)" ::: "memory");
        } else {
            XB_SPIN(xb_ld(&bar[XB_XGEN(b.x)]) == gen, bar);
            __builtin_amdgcn_fence(__ATOMIC_ACQUIRE, "agent");
            asm volatile("s_waitcnt vmcnt(0)" ::: "memory");
        }
    }
    __syncthreads();
}

struct Args { const float* in[22]; float* out; unsigned char* ws; int ph_lo, ph_hi; };

__device__ __forceinline__ const float* tr_src(int mode, const float* Wa, const float* Wb, int nd, int jj) {
    if (mode == 0) return Wa + nd + 4 * jj;
    if (mode == 1) { if (nd < 6144) return Wa + nd + 4 * jj; if (nd < 13312) return Wa + nd + 64 + 4 * jj; if (nd < 13376) return Wa + 6144 + 16 * ((nd - 13312) >> 5) + 32 * (jj & 1) + 4 * (jj >> 1); return nullptr; }
    if (mode == 2) { const int grp = nd >> 5, part = grp % 6, h = grp / 6; if (part < 4) return Wa + nd + 4 * jj; return Wa + 192 * h + 128 + 16 * (part - 4) + 32 * (jj >> 2) + 4 * (jj & 3); }
    return ((jj & 1) ? Wb : Wa) + 16 * (nd >> 5) + 4 * (jj >> 1);
}
__device__ __forceinline__ void tr_item2(int mode, const float* Wa, const float* Wb, int ldw, int k0, int n0, bf16_t* WT, int ldt, const float* ksc, float* scr, int lane) {
    const int j = lane & 15, kq = lane >> 4;
    const float* src = tr_src(mode, Wa, Wb, n0 + 32 * (j >> 3), j & 7);
    f32x4 v[16];
#pragma unroll
    for (int i = 0; i < 16; ++i) { const int kk = kq + 4 * i; v[i] = src ? *(const f32x4*)(src + (size_t)(k0 + kk) * ldw) : (f32x4){0.f, 0.f, 0.f, 0.f}; }
#pragma unroll
    for (int i = 0; i < 16; ++i) { const int kk = kq + 4 * i; f32x4 w = v[i]; if (ksc) w = w * ksc[k0 + kk]; float* d = scr + kk * 65 + 4 * j; d[0] = w[0]; d[1] = w[1]; d[2] = w[2]; d[3] = w[3]; }
    LDS_WAIT();
    const int c = lane & 7;
#pragma unroll
    for (int t = 0; t < 8; ++t) { const int n = (lane >> 3) + 8 * t; const float* sp = scr + (8 * c) * 65 + n;
        u32x4 o; o.x = pk2(sp[0 * 65], sp[1 * 65]); o.y = pk2(sp[2 * 65], sp[3 * 65]); o.z = pk2(sp[4 * 65], sp[5 * 65]); o.w = pk2(sp[6 * 65], sp[7 * 65]);
        *(u32x4*)(WT + (size_t)(n0 + n) * ldt + k0 + 8 * c) = o; }
    LDS_WAIT();
}
__device__ __forceinline__ void tr_mat(int mode, const float* Wa, const float* Wb, int K, int ldw, int N, bf16_t* WT, int ldt, const float* ksc, float* scr, int lane, int gw, int NGW) {
    const int nkb = K / 64, nit = nkb * (N / 64);
    for (int it = gw; it < nit; it += NGW) { const int nb = it / nkb, kb = it % nkb; tr_item2(mode, Wa, Wb, ldw, 64 * kb, 64 * nb, WT, ldt, ksc, scr, lane); }
}
__device__ __forceinline__ void ln_row(const float* xrow, const float* g, const float* b, float* of, bf16_t* ob, float* stats, int lane) {
    const f32x4* xr = (const f32x4*)xrow + lane;
    f32x4 v[8]; float s = 0.f;
#pragma unroll
    for (int j = 0; j < 8; ++j) { v[j] = xr[64 * j]; s += (v[j][0] + v[j][1]) + (v[j][2] + v[j][3]); }
    const float mean = wave_sum(s) * (1.f / DM); float s2 = 0.f;
#pragma unroll
    for (int j = 0; j < 8; ++j) { v[j] = v[j] - mean; s2 += (v[j][0] * v[j][0] + v[j][1] * v[j][1]) + (v[j][2] * v[j][2] + v[j][3] * v[j][3]); }
    const float rstd = rsqrtf(wave_sum(s2) * (1.f / DM) + LN_EPS);
    if (stats && lane == 0) { stats[0] = mean; stats[1] = rstd; }
#pragma unroll
    for (int j = 0; j < 8; ++j) { const f32x4 gv = ((const f32x4*)g)[64 * j + lane], bv = ((const f32x4*)b)[64 * j + lane]; const f32x4 y = v[j] * rstd * gv + bv;
        if (of) ((f32x4*)of)[64 * j + lane] = y;
        if (ob) ((u32x2*)ob)[64 * j + lane] = pk4(y); }
}

__global__ void __launch_bounds__(512) mega(Args a) {
    extern __shared__ __attribute__((aligned(16))) unsigned char lds[];
    cg::grid_group grid = cg::this_grid();
    const int tid = threadIdx.x, lane = tid & 63, wave = __builtin_amdgcn_readfirstlane(tid >> 6);
    const int G = gridDim.x, bid = blockIdx.x;
    const int gw = bid * 8 + wave, NGW = G * 8;
    unsigned char* ws = a.ws;
    LAS unsigned char* ldsl = (LAS unsigned char*)lds;
    const float* x = a.in[0]; const float* memp = a.in[1]; const int* positions = (const int*)a.in[2];
    const float *ln_emb_g = a.in[3], *ln_emb_b = a.in[4], *lb_logits = a.in[5], *w_in = a.in[6], *hg_norm_g = a.in[7], *g_cq = a.in[8], *g_ckv = a.in[9];
    const float *w_uq = a.in[10], *w_ukv = a.in[11], *w_kvm = a.in[12], *w_branch = a.in[13], *w_o = a.in[14], *ln1_g = a.in[15], *ln1_b = a.in[16];
    const float *w_gate = a.in[17], *w_up = a.in[18], *w_down = a.in[19], *ln2_g = a.in[20], *ln2_b = a.in[21];
    float* out = a.out;
    volatile LAS unsigned* xst = (volatile LAS unsigned*)(ldsl + (LDS_BYTES - 64));
    if (tid < 2) xst[tid] = 0u;
    __syncthreads();
    XcdBarrier xbar = xcd_barrier_post((unsigned*)ws, xst);
    if (a.ph_hi > 1000) grid.sync();
#define WSP(T, off) ((T*)(ws + (off)))
    float* SSQ = WSP(float, WS_SSQ); float* STATS = WSP(float, WS_STATS); float* LB = WSP(float, WS_LB);
    float* COS = WSP(float, WS_COS); float* SIN = WSP(float, WS_SIN); float* DVEC = WSP(float, WS_DVEC);
    bf16_t *WIN_T = WSP(bf16_t, WS_WIN_T), *H0B = WSP(bf16_t, WS_H0B), *WUQ_T = WSP(bf16_t, WS_WUQ_T), *WUKV_T = WSP(bf16_t, WS_WUKV_T), *WKV_T = WSP(bf16_t, WS_WKV_T), *MEMB = WSP(bf16_t, WS_MEMB);
    bf16_t *KVM = WSP(bf16_t, WS_KVM), *VMT = WSP(bf16_t, WS_VMT), *KR = WSP(bf16_t, WS_KR);
    bf16_t *QH = WSP(bf16_t, WS_QH), *VH = WSP(bf16_t, WS_VH), *GF = WSP(bf16_t, WS_GF), *GH = WSP(bf16_t, WS_GH), *CQ = WSP(bf16_t, WS_CQ), *CKV = WSP(bf16_t, WS_CKV), *QM = WSP(bf16_t, WS_QM), *GS = WSP(bf16_t, WS_GS);
    bf16_t *HS = WSP(bf16_t, WS_HS), *YA = WSP(bf16_t, WS_YA), *WBR_T = WSP(bf16_t, WS_WBR_T), *WO_T = WSP(bf16_t, WS_WO_T);
    bf16_t *KB = WSP(bf16_t, WS_KB), *VB = WSP(bf16_t, WS_VB), *QB = WSP(bf16_t, WS_QB), *SC = WSP(bf16_t, WS_SC), *PM = WSP(bf16_t, WS_PM), *YH = WSP(bf16_t, WS_YH), *YM = WSP(bf16_t, WS_YM);
    float* MERGED = WSP(float, WS_MERGED); bf16_t* MERGEDB = WSP(bf16_t, WS_MERGEDB); float* R1 = WSP(float, WS_R1); bf16_t* H1B = WSP(bf16_t, WS_H1B);
    bf16_t *WGU_T = WSP(bf16_t, WS_WGU_T), *WD_T = WSP(bf16_t, WS_WD_T), *ACT = WSP(bf16_t, WS_ACT);

#ifndef PHMASK
#define PHMASK 0x7ff
#endif
#define IN(k) (((PHMASK >> (k)) & 1) && a.ph_lo <= (k) && (k) < a.ph_hi)
#define SEAM(k) do { if (IN(k) && IN((k) + 1)) xcd_barrier(xbar); } while (0)

    if (IN(0)) {
        float* scr = (float*)lds + wave * (64 * 65);
        tr_mat(1, w_in, w_in, DM, 13376, NINP, WIN_T, LD2K, nullptr, scr, lane, gw, NGW);
        tr_mat(2, w_uq, w_uq, 512, 1536, 1536, WUQ_T, 512, g_cq, scr, lane, gw, NGW);
        tr_mat(0, w_ukv, w_ukv, 512, 2048, 2048, WUKV_T, 512, g_ckv, scr, lane, gw, NGW);
        tr_mat(0, w_kvm, w_kvm, 2048, 2048, 2048, WKV_T, DM, nullptr, scr, lane, gw, NGW);
        for (int z = 0; z < 3; ++z) tr_mat(0, w_branch + (size_t)((3 - z) % 3) * 1024 * 2048, nullptr, 1024, 2048, 2048, WBR_T + (size_t)z * 2048 * LD1K, LD1K, nullptr, scr, lane, gw, NGW);
        tr_mat(0, w_o, w_o, 2048, 2048, 2048, WO_T, LD2K, nullptr, scr, lane, gw, NGW);
        for (int m = gw; m < S; m += NGW) ln_row(x + (size_t)m * DM, ln_emb_g, ln_emb_b, nullptr, H0B + (size_t)m * LD2K, STATS + 2 * m, lane);
        const int gt = bid * 512 + tid, NGT = G * 512;
        for (int i = gt; i < S * 32; i += NGT) { const int s = i >> 5, f = i & 31;
            const double invf = exp(-(double)f * (9.210340371976184 / 32.0));
            const double t = (double)positions[s] * invf * 0.15915494309189535; const float fr = (float)(t - rint(t));
            COS[i] = __builtin_amdgcn_cosf(fr); SIN[i] = __builtin_amdgcn_sinf(fr); }
        for (int i = gt; i < 2048; i += NGT) { const int z = i >> 10, w = i & 1023; const float l0 = lb_logits[(z * 2 + 0) * 1024 + w], l1 = lb_logits[(z * 2 + 1) * 1024 + w]; LB[i] = 1.f / (1.f + __expf(l1 - l0)); }
        for (int i = gt; i < NMEM * DM / 4; i += NGT) ((u32x2*)MEMB)[i] = pk4(((const f32x4*)memp)[i]);
        __syncthreads();
    }
    SEAM(0);
    if (IN(1)) {
        {   pg8::Sched Sc; Sc.init(S, NINP, 1, G, bid); Sc.a_z = 0; Sc.A0 = (const char*)H0B; Sc.B = (const char*)WIN_T; Sc.a_pm = 256L * LD2K * 2; Sc.a_pn = 0; Sc.b_pn = 256L * LD2K * 2; Sc.b_z = 0;
            pg8::EpiP1 E{QH, VH, GF, GH, CQ, CKV, QM, GS, KR, SSQ, LB, COS, SIN};
            pg8::gemm_phase<pg8::EpiP1, true>(ldsl, LD2K, LD2K, DM, Sc, E); }
        {
            pg8::Sched Sc; Sc.init(NMEM, 1024, 1, G, bid); Sc.a_z = 0; Sc.A0 = (const char*)MEMB; Sc.B = (const char*)WKV_T; Sc.a_pm = 0; Sc.a_pn = 0; Sc.b_pn = 256L * DM * 2; Sc.b_z = 0;
            pg8::EpiStore E{KVM, 1024, 1.f};
            pg8::gemm_phase<pg8::EpiStore, true>(ldsl, DM, DM, DM, Sc, E); }
        {
            pg8::Sched Sc; Sc.init(1024, NMEM, 1, G, bid); Sc.a_z = 0; Sc.A0 = (const char*)(WKV_T + (size_t)1024 * DM); Sc.B = (const char*)MEMB; Sc.a_pm = 256L * DM * 2; Sc.a_pn = 0; Sc.b_pn = 0; Sc.b_z = 0;
            pg8::EpiStore E{VMT, 256, 1.f};
            pg8::gemm_phase<pg8::EpiStore, true>(ldsl, DM, DM, DM, Sc, E); }
    }
    SEAM(1);
    if (IN(2)) {
#ifndef DBG_SKIPG2
        {   pg8::Sched Sc; Sc.init(S, 1536, 1, G, bid); Sc.a_z = 0; Sc.A0 = (const char*)CQ; Sc.B = (const char*)WUQ_T; Sc.a_pm = 256L * 512 * 2; Sc.a_pn = 0; Sc.b_pn = 256L * 512 * 2; Sc.b_z = 0;
            pg8::EpiQ E{QB, SSQ, COS, SIN};
            pg8::gemm_phase<pg8::EpiQ, true>(ldsl, 512, 512, 512, Sc, E); }
        {   pg8::Sched Sc; Sc.init(S, 2048, 1, G, bid); Sc.a_z = 0; Sc.A0 = (const char*)CKV; Sc.B = (const char*)WUKV_T; Sc.a_pm = 256L * 512 * 2; Sc.a_pn = 0; Sc.b_pn = 256L * 512 * 2; Sc.b_z = 0;
            pg8::EpiKV E{KB, VB, SSQ + (size_t)S * 8};
            pg8::gemm_phase<pg8::EpiKV, true>(ldsl, 512, 512, 512, Sc, E); }
        {
            pg8::Sched Sc; Sc.init(S, 1024, 1, G, bid); Sc.a_z = 0; Sc.A0 = (const char*)QM; Sc.B = (const char*)KVM; Sc.a_pm = 256L * 1024 * 2; Sc.a_pn = 256 * 2; Sc.b_pn = 256 * 2; Sc.b_z = 0;
            pg8::EpiStore E{SC, 1024, 0.0625f};
            pg8::gemm_phase<pg8::EpiStore, true>(ldsl, 1024, 1024, 256, Sc, E); }
#endif
#ifdef DBG_COPY
        { const size_t gt2 = (size_t)bid * 512 + tid, NGT2 = (size_t)G * 512;
          for (size_t j = gt2; j < 16777216; j += NGT2) { HS[j] = GF[j]; HS[16777216 + j] = VH[j & 8388607]; }
          for (size_t j = gt2; j < 262144; j += NGT2) DVEC[j] = 1.f; }
#else
        {
            bf16_t* KwT = (bf16_t*)lds;
            bf16_t* VT = (bf16_t*)(lds + 18432);
            float* TOT = (float*)(lds + 36864);
            const int ch = tid & 127, sb = tid >> 7;
            for (int it = bid; it < 2048; it += G) {
                const int z = it >> 10, h = (it >> 7) & 7, c = it & 127, t0 = 64 * c;
                __syncthreads();
                float gr[16], ar[16]; float acc_a = 0.f;
#pragma unroll
                for (int r = 0; r < 16; ++r) { const int tau = 16 * sb + r, t = z ? (t0 + 63 - tau) : (t0 + tau);
                    const float g = bf2f(GF[(size_t)z * S * 1024 + (size_t)t * 1024 + 128 * h + ch]); acc_a += g; gr[r] = g; ar[r] = acc_a; }
                TOT[sb * 128 + ch] = acc_a;
#pragma unroll
                for (int j = 0; j < 2; ++j) { const int q = tid + 512 * j, tau = q >> 4, vc0 = (q & 15) * 8, t = z ? (t0 + 63 - tau) : (t0 + tau);
                    const bf16x8 v = *(const bf16x8*)(VH + (size_t)t * 1024 + 128 * h + vc0);
#pragma unroll
                    for (int e = 0; e < 8; ++e) VT[(vc0 + e) * 72 + tau] = (bf16_t)v[e]; }
                __syncthreads();
                float later = 0.f;
#pragma unroll
                for (int i2 = 1; i2 < 4; ++i2) if (i2 > sb) later += TOT[i2 * 128 + ch];
                if (sb == 0) DVEC[(size_t)it * 128 + ch] = __expf(acc_a + later);
#pragma unroll
                for (int r = 0; r < 16; ++r) { const float k = 1.f - __expf(gr[r]); KwT[ch * 72 + 16 * sb + r] = (bf16_t)f2bf(k * __expf((acc_a - ar[r]) + later)); }
                __syncthreads();
                f32x4 acc[8];
#pragma unroll
                for (int nb = 0; nb < 8; ++nb) acc[nb] = (f32x4){0.f, 0.f, 0.f, 0.f};
#pragma unroll
                for (int ks = 0; ks < 2; ++ks) { const bf16x8 A = *(const bf16x8*)(KwT + (16 * wave + (lane & 15)) * 72 + 32 * ks + (lane >> 4) * 8);
#pragma unroll
                    for (int nb = 0; nb < 8; ++nb) { const bf16x8 Bv = *(const bf16x8*)(VT + (16 * nb + (lane & 15)) * 72 + 32 * ks + (lane >> 4) * 8);
                        acc[nb] = __builtin_amdgcn_mfma_f32_16x16x32_bf16(A, Bv, acc[nb], 0, 0, 0); } }
                bf16_t* hs = HS + (size_t)it * 16384;
#pragma unroll
                for (int nb = 0; nb < 8; ++nb) *(u32x2*)(hs + (16 * nb + (lane & 15)) * 128 + 16 * wave + (lane >> 4) * 4) = pk4(acc[nb]);
            }
            __syncthreads();
        }
#endif
    }
    SEAM(2);
    if (IN(3)) {
        {
            const int gt = bid * 512 + tid, NGT = G * 512;
            for (int p = gt; p < 16 * 8192; p += NGT) { const int zh = p >> 13, e2 = p & 8191, z = zh >> 3, kch = (2 * e2) & 127;
                float s0 = 0.f, s1 = 0.f;
#pragma unroll 4
                for (int n = 0; n < 128; ++n) { const int c = z ? (127 - n) : n; const size_t it = (size_t)zh * 128 + c;
                    unsigned* pp = (unsigned*)(HS + it * 16384 + 2 * e2); const unsigned uu = *pp; const float d0 = DVEC[it * 128 + kch], d1 = DVEC[it * 128 + kch + 1];
                    *pp = cvt_pk_bf16(s0, s1);
                    s0 = d0 * s0 + __uint_as_float(uu << 16); s1 = d1 * s1 + __uint_as_float(uu & 0xffff0000u); } }
        }
        {
            for (int r = gw; r < S * 4; r += NGW) { const u32x2 w = *(const u32x2*)(SC + (size_t)r * 256 + 4 * lane); f32x4 v = unpk4(w);
                const float mx = wave_max(fmaxf(fmaxf(v[0], v[1]), fmaxf(v[2], v[3])));
#pragma unroll
                for (int e = 0; e < 4; ++e) v[e] = __expf(v[e] - mx);
                const float sm = wave_sum((v[0] + v[1]) + (v[2] + v[3])); const float inv = 1.f / sm;
                *(u32x2*)(PM + (size_t)r * 256 + 4 * lane) = pk4(v * inv); }
        }
        __syncthreads();
        for (int un = bid; un < 256; un += G) { const int h = un & 7, qb = un >> 3;
            mla::attn_unit(QB + (size_t)qb * 256 * 1536 + 192 * h, KB + 128 * h, KR, VB + 128 * h, YA + (size_t)qb * 256 * LD1K + 128 * h, S, (char*)lds); }
    }
    SEAM(3);
    if (IN(4)) {
        {   pg8::Sched Sc; Sc.init(S, 1024, 1, G, bid); Sc.a_z = 0; Sc.A0 = (const char*)PM; Sc.B = (const char*)VMT; Sc.a_pm = 256L * 1024 * 2; Sc.a_pn = 256 * 2; Sc.b_pn = 256L * 256 * 2; Sc.b_z = 0;
            pg8::EpiStore E{YM, LD1K, 1.f};
            pg8::gemm_phase<pg8::EpiStore, true>(ldsl, 1024, 256, 256, Sc, E); }
        {
            bf16_t* QT = (bf16_t*)lds;
            bf16_t* KBt = (bf16_t*)(lds + 17408);
            bf16_t* KHT = (bf16_t*)(lds + 34816);
            bf16_t* VT = (bf16_t*)(lds + 53248);
            bf16_t* ST = (bf16_t*)(lds + 71680);
            float* O = (float*)(lds + 106496);
            float* Dd = (float*)(lds + 139264);
            bf16_t* PW = (bf16_t*)(lds + 141312) + wave * 256;
            const int ch = tid & 127, sb = tid >> 7, l15 = lane & 15, l4 = lane >> 4;
            for (int it = bid; it < 1024; it += G) {
                const int h = it >> 7, c = it & 127, t0 = 64 * c;
#pragma unroll 1
                for (int z = 0; z < 2; ++z) {
                    __syncthreads();
                    {   float gr[16], ar[16]; float aa = 0.f;
#pragma unroll
                        for (int r = 0; r < 16; ++r) { const int tau = 16 * sb + r, t = z ? (t0 + 63 - tau) : (t0 + tau);
                            const float g = bf2f(GF[(size_t)z * S * 1024 + (size_t)t * 1024 + 128 * h + ch]); aa += g; gr[r] = g; ar[r] = aa; }
                        Dd[sb * 128 + ch] = __expf(aa);
#pragma unroll
                        for (int r = 0; r < 16; ++r) { const int tau = 16 * sb + r, t = z ? (t0 + 63 - tau) : (t0 + tau);
                            const float q = bf2f(QH[(size_t)t * 1024 + 128 * h + ch]); const float k = 1.f - __expf(gr[r]);
                            QT[tau * 136 + ch] = (bf16_t)f2bf(q * __expf(ar[r])); KBt[tau * 136 + ch] = (bf16_t)f2bf(k * __expf(-ar[r])); KHT[ch * 72 + tau] = (bf16_t)f2bf(k * __expf(aa - ar[r])); }
                    }
#pragma unroll
                    for (int j = 0; j < 2; ++j) { const int q = tid + 512 * j, tau = q >> 4, vc0 = (q & 15) * 8, t = z ? (t0 + 63 - tau) : (t0 + tau);
                        const bf16x8 v = *(const bf16x8*)(VH + (size_t)t * 1024 + 128 * h + vc0);
#pragma unroll
                        for (int e = 0; e < 8; ++e) VT[(vc0 + e) * 72 + tau] = (bf16_t)v[e]; }
                    {   const bf16_t* hs = HS + ((size_t)(z * 8 + h) * 128 + c) * 16384;
#pragma unroll
                        for (int j = 0; j < 4; ++j) { const int q = tid + 512 * j, vcol = q >> 4, kc = (q & 15) * 8; *(u32x4*)(ST + vcol * 136 + kc) = *(const u32x4*)(hs + vcol * 128 + kc); } }
                    __syncthreads();
                    f32x4 sacc[8];
#pragma unroll
                    for (int nb = 0; nb < 8; ++nb) { const u32x2 w = *(const u32x2*)(ST + (16 * nb + l15) * 136 + 16 * wave + l4 * 4); sacc[nb] = unpk4(w); }
#pragma unroll 1
                    for (int i = 0; i < 4; ++i) {
                        bf16x8 Aq[4];
#pragma unroll
                        for (int ks = 0; ks < 4; ++ks) Aq[ks] = *(const bf16x8*)(QT + (16 * i + l15) * 136 + 32 * ks + l4 * 8);
                        f32x4 o = (f32x4){0.f, 0.f, 0.f, 0.f}, att = (f32x4){0.f, 0.f, 0.f, 0.f};
#pragma unroll
                        for (int ks = 0; ks < 4; ++ks) { const bf16x8 Bs = *(const bf16x8*)(ST + (16 * wave + l15) * 136 + 32 * ks + l4 * 8); o = __builtin_amdgcn_mfma_f32_16x16x32_bf16(Aq[ks], Bs, o, 0, 0, 0); }
#pragma unroll
                        for (int ks = 0; ks < 4; ++ks) { const bf16x8 Bk = *(const bf16x8*)(KBt + (16 * i + l15) * 136 + 32 * ks + l4 * 8); att = __builtin_amdgcn_mfma_f32_16x16x32_bf16(Aq[ks], Bk, att, 0, 0, 0); }
#pragma unroll
                        for (int j = 0; j < 4; ++j) { const int tr = l4 * 4 + j; PW[tr * 16 + l15] = (bf16_t)f2bf((l15 <= tr) ? att[j] : 0.f); }
                        LDS_WAIT();
                        bf16x8 Ap = (bf16x8){0, 0, 0, 0, 0, 0, 0, 0}, Bv = (bf16x8){0, 0, 0, 0, 0, 0, 0, 0}, Ak = (bf16x8){0, 0, 0, 0, 0, 0, 0, 0};
                        if (lane < 32) { Ap = *(const bf16x8*)(PW + l15 * 16 + l4 * 8); Bv = *(const bf16x8*)(VT + (16 * wave + l15) * 72 + 16 * i + l4 * 8); Ak = *(const bf16x8*)(KHT + (16 * wave + l15) * 72 + 16 * i + l4 * 8); }
                        o = __builtin_amdgcn_mfma_f32_16x16x32_bf16(Ap, Bv, o, 0, 0, 0);
#pragma unroll
                        for (int j = 0; j < 4; ++j) { const int tau = 16 * i + l4 * 4 + j, tt = z ? (63 - tau) : tau; float* op = O + tt * 128 + 16 * wave + l15; if (z == 0) *op = o[j]; else *op += o[j]; }
                        if (i < 3) {
                            const f32x4 dv = *(const f32x4*)(Dd + i * 128 + 16 * wave + l4 * 4);
#pragma unroll
                            for (int nb = 0; nb < 8; ++nb) { bf16x8 Bn = (bf16x8){0, 0, 0, 0, 0, 0, 0, 0}; if (lane < 32) Bn = *(const bf16x8*)(VT + (16 * nb + l15) * 72 + 16 * i + l4 * 8);
                                sacc[nb] = __builtin_amdgcn_mfma_f32_16x16x32_bf16(Ak, Bn, sacc[nb] * dv, 0, 0, 0); }
                            __syncthreads();
#pragma unroll
                            for (int nb = 0; nb < 8; ++nb) *(u32x2*)(ST + (16 * nb + l15) * 136 + 16 * wave + l4 * 4) = pk4(sacc[nb]);
                            __syncthreads();
                        }
                    }
                }
                __syncthreads();
#pragma unroll 1
                for (int k2 = 0; k2 < 8; ++k2) { const int tt = 8 * wave + k2; const float v0 = O[tt * 128 + lane], v1 = O[tt * 128 + 64 + lane];
                    const float r = rsqrtf(wave_sum(v0 * v0 + v1 * v1) * (1.f / 128.f) + RMS_EPS); const size_t base = (size_t)(t0 + tt) * 1024 + 128 * h, ybase = (size_t)(t0 + tt) * LD1K + 128 * h;
                    YH[ybase + lane] = (bf16_t)f2bf(v0 * r * hg_norm_g[lane] * bf2f(GH[base + lane]));
                    YH[ybase + 64 + lane] = (bf16_t)f2bf(v1 * r * hg_norm_g[64 + lane] * bf2f(GH[base + 64 + lane])); }
            }
            __syncthreads();
        }
    }
    SEAM(4);
    if (IN(5)) {
        pg8::Sched Sc; Sc.init(S, DM, 3, G, bid); Sc.A0 = (const char*)YH; Sc.a_z = 17L * 1024 * 1024; Sc.B = (const char*)WBR_T; Sc.a_pm = 256L * LD1K * 2; Sc.a_pn = 0; Sc.b_pn = 256L * LD1K * 2; Sc.b_z = 2048L * LD1K * 2;
        pg8::EpiMerge E{GS, MERGED, MERGEDB};
        pg8::gemm_phase<pg8::EpiMerge, true>(ldsl, LD1K, LD1K, 1024, Sc, E);
    }
    SEAM(5);
    if (IN(6)) {
        pg8::Sched Sc; Sc.init(S, DM, 1, G, bid); Sc.a_z = 0; Sc.A0 = (const char*)MERGEDB; Sc.B = (const char*)WO_T; Sc.a_pm = 256L * LD2K * 2; Sc.a_pn = 0; Sc.b_pn = 256L * LD2K * 2; Sc.b_z = 0;
        pg8::EpiWo E{x, STATS, ln_emb_g, ln_emb_b, R1};
        pg8::gemm_phase<pg8::EpiWo, true>(ldsl, LD2K, LD2K, DM, Sc, E);
    }
    SEAM(6);
    if (IN(7)) {
        for (int m = gw; m < S; m += NGW) ln_row(R1 + (size_t)m * DM, ln1_g, ln1_b, R1 + (size_t)m * DM, H1B + (size_t)m * LD2K, nullptr, lane);
        float* scr = (float*)lds + wave * (64 * 65);
        tr_mat(3, w_gate, w_up, DM, DFF, 2 * DFF, WGU_T, LD2K, nullptr, scr, lane, gw, NGW);
        tr_mat(0, w_down, w_down, DFF, DM, DM, WD_T, LDACT, nullptr, scr, lane, gw, NGW);
        __syncthreads();
    }
    SEAM(7);
    if (IN(8)) {
        pg8::Sched Sc; Sc.init(S, 2 * DFF, 1, G, bid); Sc.a_z = 0; Sc.A0 = (const char*)H1B; Sc.B = (const char*)WGU_T; Sc.a_pm = 256L * LD2K * 2; Sc.a_pn = 0; Sc.b_pn = 256L * LD2K * 2; Sc.b_z = 0;
        pg8::EpiGU E{ACT};
        pg8::gemm_phase<pg8::EpiGU, true>(ldsl, LD2K, LD2K, DM, Sc, E);
    }
    SEAM(8);
    if (IN(9)) {
        pg8::Sched Sc; Sc.init(S, DM, 1, G, bid); Sc.a_z = 0; Sc.A0 = (const char*)ACT; Sc.B = (const char*)WD_T; Sc.a_pm = 256L * LDACT * 2; Sc.a_pn = 0; Sc.b_pn = 256L * LDACT * 2; Sc.b_z = 0;
        pg8::EpiDown E{R1, out};
        pg8::gemm_phase<pg8::EpiDown, true>(ldsl, LDACT, LDACT, DFF, Sc, E);
    }
    SEAM(9);
    if (IN(10)) {
        for (int m = gw; m < S; m += NGW) ln_row(out + (size_t)m * DM, ln2_g, ln2_b, out + (size_t)m * DM, nullptr, nullptr, lane);
    }
#ifdef DBG_STOP
    {
        asm volatile("s_waitcnt vmcnt(0)" ::: "memory"); __threadfence(); grid.sync(); __builtin_amdgcn_fence(__ATOMIC_ACQUIRE, "agent"); asm volatile("s_waitcnt vmcnt(0)" ::: "memory");
        const size_t NO = (size_t)S * DM; const size_t gt = (size_t)bid * 512 + tid, NGT = (size_t)G * 512;
#define DB(ptr, n) for (size_t j = i; j < (size_t)(n); j += NO) acc += bf2f(((const bf16_t*)(ptr))[j]);
#define DF(ptr, n) for (size_t j = i; j < (size_t)(n); j += NO) acc += ((const float*)(ptr))[j];
        for (size_t i = gt; i < NO; i += NGT) { float acc = 0.f;
#if DBG_STOP == 0
            DB(WIN_T, 27787264) DB(H0B, 16777216) DB(WUQ_T, 786432) DB(WUKV_T, 1048576) DB(WKV_T, 4194304) DB(MEMB, 524288) DB(WBR_T, 6291456) DB(WO_T, 4194304) DF(STATS, 16384) DF(LB, 2048) DF(COS, 262144) DF(SIN, 262144)
#elif DBG_STOP == 1
            DB(QH, 8388608) DB(VH, 8388608) DB(GF, 16777216) DB(GH, 8388608) DB(CQ, 4194304) DB(CKV, 4194304) DB(QM, 8388608) DB(GS, 50331648) DB(KR, 524288) DB(KVM, 262144) DB(VMT, 262144) DF(SSQ, 131072)
#elif DBG_STOP == 2
            DB(QB, 12582912) DB(KB, 8388608) DB(VB, 8388608) DB(SC, 8388608) DB(HS, 33554432) DF(DVEC, 262144)
#elif DBG_STOP == 3
            DB(HS, 33554432) DB(PM, 8388608) DB(YA, 8388608)
#elif DBG_STOP == 4
            DB(YM, 8388608) DB(YH, 8388608)
#elif DBG_STOP == 5
            DB(MERGEDB, 16777216) DF(MERGED, 16777216)
#elif DBG_STOP == 6
            DF(R1, 16777216)
#elif DBG_STOP == 7
            DF(R1, 16777216) DB(H1B, 16777216) DB(WGU_T, 23068672) DB(WD_T, 11534336)
#elif DBG_STOP == 8
            DB(ACT, 46137344)
#endif
            out[i] = acc; }
    }
#endif
}

extern "C" void kernel_launch(void* const* d_in, const int* in_sizes, int n_in, void* d_out, int out_size, void* d_ws, size_t ws_size, hipStream_t stream) {
    static int grid = 0;
    if (grid == 0) {
        if (n_in != 22 || out_size != S * DM || ws_size < WS_END) { fprintf(stderr, "kernel_launch: unexpected shapes (n_in %d out %d ws %zu, need %zu)\n", n_in, out_size, ws_size, (size_t)WS_END); grid = -1; return; }
        int dev = 0, cus = 0, per_cu = 0;
        hipGetDevice(&dev); hipDeviceGetAttribute(&cus, hipDeviceAttributeMultiprocessorCount, dev);
        if (hipFuncSetAttribute((const void*)mega, hipFuncAttributeMaxDynamicSharedMemorySize, LDS_BYTES) != hipSuccess) { fprintf(stderr, "kernel_launch: hipFuncSetAttribute failed\n"); grid = -1; return; }
        if (hipOccupancyMaxActiveBlocksPerMultiprocessor(&per_cu, (const void*)mega, 512, LDS_BYTES) != hipSuccess || per_cu < 1) { fprintf(stderr, "kernel_launch: occupancy query failed (%d)\n", per_cu); per_cu = 1; (void)hipGetLastError(); }
        grid = cus * 1;
    }
    if (grid < 0) return;
    (void)hipMemsetAsync(d_ws, 0, 16384, stream);
    Args a{};
    for (int i = 0; i < 22; ++i) a.in[i] = (const float*)d_in[i];
    a.out = (float*)d_out; a.ws = (unsigned char*)d_ws; a.ph_lo = 0; a.ph_hi = 11;
#ifdef DBG_STOP
    a.ph_hi = DBG_STOP + 1;
#endif
    void* args[] = {&a};
#ifdef PROBE_K
    {   Args b = a; b.ph_hi = PROBE_K + 1; void* bargs[] = {&b};
        (void)hipLaunchCooperativeKernel((const void*)mega, dim3(grid), dim3(512), bargs, LDS_BYTES, stream); }
#endif
    hipError_t e = hipLaunchCooperativeKernel((const void*)mega, dim3(grid), dim3(512), args, LDS_BYTES, stream);
    if (e != hipSuccess) fprintf(stderr, "cooperative launch failed: %s (grid %d)\n", hipGetErrorString(e), grid);
}
```
